# Optimizing an MI355X kernel written in HIP

```python
import math
import jax, jax.numpy as jnp
from jax import lax
import numpy as np

D_MODEL = 2048
BATCH = 4
SEQ = 4096
DEPTH = 2

N_A_LAYERS = DEPTH // 2
N_B_LAYERS = DEPTH - N_A_LAYERS
HEAD_DIM = 128
MEM_LEN = 256
MEM_HEADS = 4
MEM_WIDTH = MEM_HEADS * HEAD_DIM
MIX_WIDTH = D_MODEL
TOK_WIDTH = MIX_WIDTH - MEM_WIDTH
CHUNK = 128
SGU_GROUPS = TOK_WIDTH // HEAD_DIM
MLA_HEADS = TOK_WIDTH // HEAD_DIM
QK_NOPE = 128
QK_ROPE = 64
V_DIM = 128
Q_LORA = 512
KV_LORA = 512
ROPE_THETA = 10000.0
D_FF = ((8 * D_MODEL + 3 * 256 - 1) // (3 * 256)) * 256
Q_BLOCK = 128
EPS = 1e-6
MLA_SCALE = (QK_NOPE + QK_ROPE) ** -0.5
MEM_SCALE = HEAD_DIM ** -0.5
A_IN_WIDTH = 2 * TOK_WIDTH + MEM_WIDTH
B_IN_WIDTH = Q_LORA + MEM_WIDTH

kernel_name = "yoco_gmlp_mla_memory_hybrid"


def rms_norm(x, g):
    xf = x.astype(jnp.float32)
    y = xf * lax.rsqrt(jnp.mean(xf * xf, axis=-1, keepdims=True) + EPS)
    return (y * g.astype(jnp.float32)).astype(x.dtype)


def layer_norm(x, g, b):
    xf = x.astype(jnp.float32)
    mu = jnp.mean(xf, axis=-1, keepdims=True)
    xc = xf - mu
    y = xc * lax.rsqrt(jnp.mean(xc * xc, axis=-1, keepdims=True) + EPS)
    return (y * g.astype(jnp.float32) + b.astype(jnp.float32)).astype(x.dtype)


def rope_tables(positions):
    inv_freq = ROPE_THETA ** (-jnp.arange(0, QK_ROPE, 2, dtype=jnp.float32) / QK_ROPE)
    ang = positions.astype(jnp.float32)[..., None] * inv_freq
    return jnp.cos(ang), jnp.sin(ang)


def apply_rope(x, cos, sin):
    x1, x2 = jnp.split(x.astype(jnp.float32), 2, axis=-1)
    out = jnp.concatenate([x1 * cos - x2 * sin, x2 * cos + x1 * sin], axis=-1)
    return out.astype(x.dtype)


def swiglu_ffn(h, w_gate, w_up, w_down):
    return (jax.nn.silu(h @ w_gate) * (h @ w_up)) @ w_down


def memory_attention(q, mem, mem_g, w_mem_kv):
    B, S, _ = q.shape
    kv = rms_norm(mem, mem_g) @ w_mem_kv
    k, v = jnp.split(kv, 2, axis=-1)
    k = k.reshape(B, -1, MEM_HEADS, HEAD_DIM)
    v = v.reshape(B, -1, MEM_HEADS, HEAD_DIM)
    q = q.reshape(B, S, MEM_HEADS, HEAD_DIM)
    s = jnp.einsum('bqhd,bmhd->bhqm', q, k).astype(jnp.float32) * MEM_SCALE
    p = jax.nn.softmax(s, axis=-1).astype(v.dtype)
    return jnp.einsum('bhqm,bmhd->bqhd', p, v).reshape(B, S, MEM_WIDTH)


def gmlp_spatial_gating(z, ln_g, ln_b, w_s, b_s):
    B, S, _ = z.shape
    z = jax.nn.gelu(z)
    u, v = jnp.split(z, 2, axis=-1)
    v = layer_norm(v, ln_g, ln_b)
    v = v.reshape(B, S // CHUNK, CHUNK, SGU_GROUPS, HEAD_DIM)
    causal = jnp.tril(jnp.ones((CHUNK, CHUNK), dtype=bool))
    w = jnp.where(causal[None], w_s, jnp.zeros_like(w_s))
    s = jnp.einsum('gts,bnsgc->bntgc', w, v) + b_s.T[None, None, :, :, None]
    return u * s.reshape(B, S, TOK_WIDTH)


def causal_mla(q_nope, q_rope, k_nope, k_rope, v):
    B, S, H, _ = q_nope.shape
    nb = S // Q_BLOCK
    qn = q_nope.reshape(B, nb, Q_BLOCK, H, QK_NOPE).transpose(1, 0, 2, 3, 4)
    qr = q_rope.reshape(B, nb, Q_BLOCK, H, QK_ROPE).transpose(1, 0, 2, 3, 4)
    k_idx = jnp.arange(S)

    def block(args):
        i, qn_b, qr_b = args
        s = (jnp.einsum('bqhd,bkhd->bhqk', qn_b, k_nope)
             + jnp.einsum('bqhr,bkr->bhqk', qr_b, k_rope)).astype(jnp.float32) * MLA_SCALE
        q_idx = i * Q_BLOCK + jnp.arange(Q_BLOCK)
        mask = q_idx[:, None] >= k_idx[None, :]
        s = jnp.where(mask[None, None], s, jnp.finfo(jnp.float32).min)
        p = jax.nn.softmax(s, axis=-1).astype(v.dtype)
        return jnp.einsum('bhqk,bkhd->bqhd', p, v)

    out = lax.map(block, (jnp.arange(nb), qn, qr))
    return out.transpose(1, 0, 2, 3, 4).reshape(B, S, H * V_DIM)


def shared_latent_kv(h, kv_src_norm, w_kv_a, kv_norm, w_uk, w_uv, cos, sin):
    B, S, _ = h.shape
    a = rms_norm(h, kv_src_norm) @ w_kv_a
    c_kv = rms_norm(a[..., :KV_LORA], kv_norm)
    k_rope = apply_rope(a[..., KV_LORA:], cos, sin)
    k_nope = (c_kv @ w_uk).reshape(B, S, MLA_HEADS, QK_NOPE)
    v = (c_kv @ w_uv).reshape(B, S, MLA_HEADS, V_DIM)
    return k_nope, k_rope, v


def setup_inputs(seed: int = 0) -> dict:
    key = jax.random.key(seed)
    ks = iter(jax.random.split(key, 32))
    f32 = jnp.float32

    def w(shape, fan_in):
        return jax.random.normal(next(ks), shape, f32) * (fan_in ** -0.5)

    def gain(shape):
        return 1.0 + 0.02 * jax.random.normal(next(ks), shape, f32)

    x = jax.random.normal(next(ks), (BATCH, SEQ, D_MODEL), f32)
    mem = jax.random.normal(next(ks), (BATCH, MEM_LEN, D_MODEL), f32)
    offset = jax.random.randint(next(ks), (BATCH, 1), 0, 4096, dtype=jnp.int32)
    positions = offset + jnp.arange(SEQ, dtype=jnp.int32)[None, :]
    return {
        "x": x,
        "mem": mem,
        "positions": positions,
        "norm_gains": gain((DEPTH, 4, D_MODEL)),
        "mem_norm": gain((DEPTH, D_MODEL)),
        "w_mem_kv": w((DEPTH, D_MODEL, 2 * MEM_WIDTH), D_MODEL),
        "ffn_w_gate": w((DEPTH, D_MODEL, D_FF), D_MODEL),
        "ffn_w_up": w((DEPTH, D_MODEL, D_FF), D_MODEL),
        "ffn_w_down": w((DEPTH, D_FF, D_MODEL), D_FF),
        "a_w_in": w((N_A_LAYERS, D_MODEL, A_IN_WIDTH), D_MODEL),
        "a_ln_g": gain((N_A_LAYERS, TOK_WIDTH)),
        "a_ln_b": 0.02 * jax.random.normal(next(ks), (N_A_LAYERS, TOK_WIDTH), f32),
        "a_w_s": w((N_A_LAYERS, SGU_GROUPS, CHUNK, CHUNK), CHUNK),
        "a_b_s": gain((N_A_LAYERS, SGU_GROUPS, CHUNK)),
        "a_w_out": w((N_A_LAYERS, MIX_WIDTH, D_MODEL), MIX_WIDTH),
        "kv_src_norm": gain((D_MODEL,)),
        "w_kv_a": w((D_MODEL, KV_LORA + QK_ROPE), D_MODEL),
        "kv_norm": gain((KV_LORA,)),
        "w_uk": w((KV_LORA, MLA_HEADS * QK_NOPE), KV_LORA),
        "w_uv": w((KV_LORA, MLA_HEADS * V_DIM), KV_LORA),
        "b_w_in": w((N_B_LAYERS, D_MODEL, B_IN_WIDTH), D_MODEL),
        "b_q_norm": gain((N_B_LAYERS, Q_LORA)),
        "b_w_uq": w((N_B_LAYERS, Q_LORA, MLA_HEADS * (QK_NOPE + QK_ROPE)), Q_LORA),
        "b_w_out": w((N_B_LAYERS, MIX_WIDTH, D_MODEL), MIX_WIDTH),
    }


def reference(x, mem, positions, norm_gains, mem_norm, w_mem_kv, ffn_w_gate, ffn_w_up,
              ffn_w_down, a_w_in, a_ln_g, a_ln_b, a_w_s, a_b_s, a_w_out, kv_src_norm,
              w_kv_a, kv_norm, w_uk, w_uv, b_w_in, b_q_norm, b_w_uq, b_w_out):
    B, S, _ = x.shape
    cos, sin = rope_tables(positions)
    h = x
    k_nope = k_rope = v_shared = None
    for i in range(DEPTH):
        hn = rms_norm(h, norm_gains[i, 0])
        if i < N_A_LAYERS:
            j = i
            z = hn @ a_w_in[j]
            tok = gmlp_spatial_gating(z[..., :2 * TOK_WIDTH], a_ln_g[j], a_ln_b[j],
                                      a_w_s[j], a_b_s[j])
            memo = memory_attention(z[..., 2 * TOK_WIDTH:], mem, mem_norm[i], w_mem_kv[i])
            mix = jnp.concatenate([tok, memo], axis=-1) @ a_w_out[j]
        else:
            j = i - N_A_LAYERS
            if j == 0:
                k_nope, k_rope, v_shared = shared_latent_kv(
                    h, kv_src_norm, w_kv_a, kv_norm, w_uk, w_uv, cos, sin)
            z = hn @ b_w_in[j]
            cq = rms_norm(z[..., :Q_LORA], b_q_norm[j])
            q = (cq @ b_w_uq[j]).reshape(B, S, MLA_HEADS, QK_NOPE + QK_ROPE)
            q_nope = q[..., :QK_NOPE]
            q_rope = apply_rope(q[..., QK_NOPE:], cos[:, :, None, :], sin[:, :, None, :])
            att = causal_mla(q_nope, q_rope, k_nope, k_rope, v_shared)
            memo = memory_attention(z[..., Q_LORA:], mem, mem_norm[i], w_mem_kv[i])
            mix = jnp.concatenate([att, memo], axis=-1) @ b_w_out[j]
        h = h + rms_norm(mix, norm_gains[i, 1])
        f = swiglu_ffn(rms_norm(h, norm_gains[i, 2]), ffn_w_gate[i], ffn_w_up[i], ffn_w_down[i])
        h = h + rms_norm(f, norm_gains[i, 3])
    return h
```

```cpp
#include <hip/hip_runtime.h>
#include <hip/hip_cooperative_groups.h>
#include <cstdio>
#include <cstdint>
namespace cg = cooperative_groups;
namespace pg8 {
#define PG8_LAS __attribute__((address_space(3)))
typedef unsigned short bf16_t;
typedef short bf16x8 __attribute__((ext_vector_type(8)));
typedef float f32x4 __attribute__((ext_vector_type(4)));
typedef unsigned u32x4 __attribute__((ext_vector_type(4)));
constexpr int BM = 256, BK = 64, HALF = 128, HTB = HALF * BK * 2  , STAGE_BYTES = 8 * HTB, NXCD = 8, WGM = 8;

__host__ __device__ __forceinline__ int lds_byte(int r, int c) { const int st = (r >> 4) * 2 + (c >> 5), rr = r & 15, cc = c & 31, ob = rr * 64 + cc * 2; return st * 1024 + (ob ^ (((ob >> 9) & 1) << 5)); }
__host__ __device__ __forceinline__ void stage_rc(int b, int& R, int& C) { const int st = b / 1024, sb = b % 1024, swz = sb ^ (((sb >> 9) & 1) << 5); R = (st >> 1) * 16 + swz / 64; C = (st & 1) * 32 + (swz % 64) / 2; }
__host__ __device__ __forceinline__ int perm32(int rho) { const int n = rho >> 4, i = rho & 15; return 8 * (i >> 2) + 4 * n + (i & 3); }

struct Unit { int pm, pn; };
struct Gemm { const bf16_t* A; const bf16_t* Bt; int M, N, K; };

struct StaticOrder {
    int nM, nN, nwg, G, c;
    __host__ __device__ void init(int M, int N, int G_, int c_) { nM = M / BM; nN = N / BM; nwg = nM * nN; G = G_; c = c_; }
    __host__ __device__ bool next(int i, Unit& u) const {
        const long L = (long)i * G + c; if (L >= nwg) return false;
        int wgid = (int)L; { const int q = nwg / NXCD, r = nwg % NXCD, xcd = wgid % NXCD, off = wgid / NXCD; wgid = (xcd < r ? xcd * (q + 1) : r * (q + 1) + (xcd - r) * q) + off; }
        const int nig = WGM * nN, gid = wgid / nig, fm = gid * WGM, gsz = (nM - fm) < WGM ? (nM - fm) : WGM;
        u.pm = fm + ((wgid % nig) % gsz); u.pn = (wgid % nig) / gsz; return true;
    }
    __device__ __forceinline__ void a_ready(const Unit&) const {}
    __device__ __forceinline__ void done(const Unit&) const {}
};

__device__ __forceinline__ unsigned cvt_pk_bf16(float lo, float hi) { unsigned r; asm volatile("v_cvt_pk_bf16_f32 %0, %1, %2" : "=v"(r) : "v"(lo), "v"(hi)); return r; }
template <class Epi, class Sched, bool ALIGN_EPI = false, bool SP2 = false>
__device__ __forceinline__ void gemm_phase(PG8_LAS unsigned char* lds, const Gemm g, const Sched& S, const Epi& E) {
    int tid_raw = threadIdx.x; asm volatile("" : "+v"(tid_raw));
    const int tid = tid_raw, wid = __builtin_amdgcn_readfirstlane(tid >> 6), lane = tid & 63, wr = wid >> 2, wc = wid & 3, fr = lane & 15, fq = lane >> 4;
    const int K = g.K, nt = K / BK;
    unsigned voffA[2], voffB[2];
#pragma unroll
    for (int i = 0; i < 2; ++i) { int R, C; stage_rc(tid * 16 + i * 8192, R, C); const int Rb = Epi::PERM ? ((R & ~31) + perm32(R & 31)) : R;
        voffA[i] = (unsigned)(R * K + C) * 2u; voffB[i] = (unsigned)(Rb * K + C) * 2u; }
    const size_t kstep = (size_t)(BK * 2);
    const size_t hstep = (size_t)HALF * K * 2;
    const size_t tstep = 2 * hstep;
    const unsigned ldsw = (unsigned)wid * 1024u;
    const int aoff = lds_byte(wr * 64 + fr, fq * 8), boff = lds_byte(wc * 32 + fr, fq * 8);
#define PG8_SA(b, h) (((b) * 2 + (h)) * HTB)
#define PG8_SB(b, h) ((4 + (b) * 2 + (h)) * HTB)
#define PG8_STAGE(bufoff, gbase, voff) do { _Pragma("unroll") for (int _i = 0; _i < 2; ++_i) \
        __builtin_amdgcn_global_load_lds((const unsigned*)((const char*)(gbase) + (voff)[_i]), (PG8_LAS unsigned*)(lds + (bufoff) + ldsw + _i * 8192), 16, 0, 0); } while (0)
#define PG8_LDA(dst, b, h) do { _Pragma("unroll") for (int m = 0; m < 4; ++m) _Pragma("unroll") for (int k = 0; k < 2; ++k) dst[m][k] = *(const PG8_LAS bf16x8*)(lds + PG8_SA(b, h) + aoff + m * 2048 + k * 1024); } while (0)
#define PG8_LDB(dst, b, h) do { _Pragma("unroll") for (int n = 0; n < 2; ++n) _Pragma("unroll") for (int k = 0; k < 2; ++k) dst[n][k] = *(const PG8_LAS bf16x8*)(lds + PG8_SB(b, h) + boff + n * 2048 + k * 1024); } while (0)
#define PG8_MMA(ai, bj, At, Bt) do { __builtin_amdgcn_s_setprio(1); _Pragma("unroll") for (int m = 0; m < 4; ++m) _Pragma("unroll") for (int n = 0; n < 2; ++n) _Pragma("unroll") for (int k = 0; k < 2; ++k) \
        acc[ai][bj][m][n] = __builtin_amdgcn_mfma_f32_16x16x32_bf16(Bt[n][k], At[m][k], acc[ai][bj][m][n], 0, 0, 0); __builtin_amdgcn_s_setprio(0); } while (0)
#define PG8_WAIT_V(n) asm volatile("s_waitcnt vmcnt(" #n ")" ::: "memory")
#define PG8_WAIT_L(n) asm volatile("s_waitcnt lgkmcnt(" #n ")" ::: "memory")
#define PG8_BAR __builtin_amdgcn_s_barrier()
#define PG8_SCHED __builtin_amdgcn_sched_barrier(0)
    Unit cur, nxt; int ui = 0;
    if (!S.next(0, cur)) return;
    f32x4 acc[2][2][4][2];
#pragma unroll
    for (int a = 0; a < 2; ++a)
#pragma unroll
        for (int b = 0; b < 2; ++b)
#pragma unroll
            for (int m = 0; m < 4; ++m)
#pragma unroll
                for (int n = 0; n < 2; ++n) acc[a][b][m][n] = (f32x4){0.f, 0.f, 0.f, 0.f};
    bf16x8 At[4][2], B0[2][2], B1[2][2];
    const char* cA = (const char*)g.A + (size_t)cur.pm * tstep; const char* cB = (const char*)g.Bt + (size_t)cur.pn * tstep;
    S.a_ready(cur);
    if constexpr (SP2) {
        PG8_STAGE(PG8_SB(0, 0), cB, voffB); PG8_STAGE(PG8_SB(0, 1), cB + hstep, voffB); PG8_STAGE(PG8_SA(0, 0), cA, voffA); PG8_STAGE(PG8_SA(0, 1), cA + hstep, voffA);
        if (wr == 1) PG8_BAR;
        PG8_WAIT_V(2); PG8_BAR;
        PG8_STAGE(PG8_SB(1, 0), cB + kstep, voffB); PG8_STAGE(PG8_SA(1, 0), cA + kstep, voffA); PG8_STAGE(PG8_SB(1, 1), cB + hstep + kstep, voffB);
        PG8_WAIT_V(6); PG8_BAR;
    } else {
        PG8_STAGE(PG8_SB(0, 0), cB, voffB); PG8_STAGE(PG8_SA(0, 0), cA, voffA); PG8_STAGE(PG8_SB(0, 1), cB + hstep, voffB); PG8_STAGE(PG8_SA(0, 1), cA + hstep, voffA);
        if (wr == 1) PG8_BAR;
        PG8_WAIT_V(4); PG8_BAR;
        PG8_STAGE(PG8_SB(1, 0), cB + kstep, voffB); PG8_STAGE(PG8_SA(1, 0), cA + kstep, voffA); PG8_STAGE(PG8_SB(1, 1), cB + hstep + kstep, voffB);
        PG8_WAIT_V(6); PG8_BAR;
    }
    for (;;) {
        const bool has_next = S.next(ui + 1, nxt);
        const char* nA = has_next ? (const char*)g.A + (size_t)nxt.pm * tstep : cA; const char* nB = has_next ? (const char*)g.Bt + (size_t)nxt.pn * tstep : cB;
        for (int t = 0; t < nt; t += 2) {
            const bool last = (t == nt - 2);
            const char* a1 = cA + (size_t)(t + 1) * kstep;
            const char* a2 = last ? nA : cA + (size_t)(t + 2) * kstep; const char* b2 = last ? nB : cB + (size_t)(t + 2) * kstep;
            const char* a3 = a2 + kstep; const char* b3 = b2 + kstep;
            if (last && has_next) S.a_ready(nxt);
            if constexpr (SP2) {
            PG8_LDB(B0, 0, 0); PG8_LDB(B1, 0, 1); PG8_SCHED; PG8_LDA(At, 0, 0); PG8_STAGE(PG8_SA(1, 1), a1 + hstep, voffA);
            PG8_WAIT_V(8); PG8_WAIT_L(0); PG8_BAR; PG8_MMA(0, 0, At, B0); PG8_MMA(0, 1, At, B1); PG8_BAR; PG8_SCHED;
            PG8_LDA(At, 0, 1); PG8_STAGE(PG8_SB(0, 0), b2, voffB); PG8_STAGE(PG8_SB(0, 1), b2 + hstep, voffB); PG8_STAGE(PG8_SA(0, 0), a2, voffA);
            PG8_WAIT_V(8); PG8_WAIT_L(0); PG8_BAR; PG8_MMA(1, 0, At, B0); PG8_MMA(1, 1, At, B1); PG8_BAR; PG8_SCHED;
            PG8_LDB(B0, 1, 0); PG8_LDB(B1, 1, 1); PG8_SCHED; PG8_LDA(At, 1, 0); PG8_STAGE(PG8_SA(0, 1), a2 + hstep, voffA);
            PG8_WAIT_V(8); PG8_WAIT_L(0); PG8_BAR; PG8_MMA(0, 0, At, B0); PG8_MMA(0, 1, At, B1); PG8_BAR; PG8_SCHED;
            PG8_LDA(At, 1, 1); PG8_STAGE(PG8_SB(1, 0), b3, voffB); PG8_STAGE(PG8_SB(1, 1), b3 + hstep, voffB); PG8_STAGE(PG8_SA(1, 0), a3, voffA);
            PG8_WAIT_V(8); PG8_WAIT_L(0); PG8_BAR; PG8_MMA(1, 0, At, B0); PG8_MMA(1, 1, At, B1); PG8_BAR; PG8_SCHED;
            } else {
            PG8_LDB(B0, 0, 0); PG8_SCHED; PG8_LDA(At, 0, 0); PG8_STAGE(PG8_SA(1, 1), a1 + hstep, voffA);
            PG8_WAIT_L(8); PG8_BAR; PG8_WAIT_L(0); PG8_MMA(0, 0, At, B0); PG8_BAR; PG8_SCHED;
            PG8_LDB(B1, 0, 1); PG8_STAGE(PG8_SB(0, 0), b2, voffB);
            PG8_BAR; PG8_WAIT_L(0); PG8_MMA(0, 1, At, B1); PG8_BAR;
            PG8_LDA(At, 0, 1); PG8_STAGE(PG8_SA(0, 0), a2, voffA);
            PG8_BAR; PG8_WAIT_L(0); PG8_MMA(1, 0, At, B0); PG8_BAR; PG8_SCHED;
            PG8_STAGE(PG8_SB(0, 1), b2 + hstep, voffB);
            PG8_WAIT_V(6); PG8_BAR; PG8_MMA(1, 1, At, B1); PG8_BAR;
            PG8_LDB(B0, 1, 0); PG8_SCHED; PG8_LDA(At, 1, 0); PG8_STAGE(PG8_SA(0, 1), a2 + hstep, voffA);
            PG8_WAIT_L(8); PG8_BAR; PG8_WAIT_L(0); PG8_MMA(0, 0, At, B0); PG8_BAR; PG8_SCHED;
            PG8_LDB(B1, 1, 1); PG8_STAGE(PG8_SB(1, 0), b3, voffB);
            PG8_BAR; PG8_WAIT_L(0); PG8_MMA(0, 1, At, B1); PG8_BAR;
            PG8_LDA(At, 1, 1); PG8_STAGE(PG8_SA(1, 0), a3, voffA);
            PG8_BAR; PG8_WAIT_L(0); PG8_MMA(1, 0, At, B0); PG8_BAR; PG8_SCHED;
            PG8_STAGE(PG8_SB(1, 1), b3 + hstep, voffB);
            PG8_WAIT_V(6); PG8_BAR; PG8_MMA(1, 1, At, B1); PG8_BAR;
            }
        }
        if constexpr (ALIGN_EPI) { if (wr == 0) PG8_BAR; }
        if constexpr (!Epi::AFTER_DRAIN) { E(acc, cur, wr, wc, fr, fq); S.done(cur); }
        if (!has_next) break;
#pragma unroll
        for (int a = 0; a < 2; ++a)
#pragma unroll
            for (int b = 0; b < 2; ++b)
#pragma unroll
                for (int m = 0; m < 4; ++m)
#pragma unroll
                    for (int n = 0; n < 2; ++n) acc[a][b][m][n] = (f32x4){0.f, 0.f, 0.f, 0.f};
        cur = nxt; cA = nA; cB = nB; ++ui;
        if constexpr (ALIGN_EPI) { if (wr == 1) PG8_BAR; }
    }
    PG8_WAIT_V(0);
    if constexpr (!ALIGN_EPI) { if (wr == 0) PG8_BAR; }
    PG8_BAR;
    if constexpr (Epi::AFTER_DRAIN) { E.fused(acc, cur, wr, wc, fr, fq, lds, wid, lane); S.done(cur); }
#undef PG8_SA
#undef PG8_SB
#undef PG8_STAGE
#undef PG8_LDA
#undef PG8_LDB
#undef PG8_MMA
#undef PG8_WAIT_V
#undef PG8_WAIT_L
#undef PG8_BAR
#undef PG8_SCHED
}
}

#define LAS __attribute__((address_space(3)))
typedef unsigned short bf16;
typedef unsigned v4u __attribute__((ext_vector_type(4)));
typedef unsigned v2u __attribute__((ext_vector_type(2)));
typedef float v4f __attribute__((ext_vector_type(4)));
typedef float v16f __attribute__((ext_vector_type(16)));
typedef short v8s __attribute__((ext_vector_type(8)));

constexpr int NTOK = 16384, DM = 2048, SEQ = 4096, DFF = 5632, TOKW = 1536;
constexpr float EPS = 1e-6f;
constexpr float LOG2E = 1.4426950408889634f;
constexpr float QSCALE_MLA = 0.07216878364870322f * LOG2E, QSCALE_MEM = 0.08838834764831845f * LOG2E;

constexpr size_t MiB = 1u << 20;
constexpr size_t WS_CTL = 0;
constexpr size_t WS_COS = 1 * MiB, WS_SIN = 3 * MiB;
constexpr size_t WS_MEMN = 5 * MiB, WS_KMEM = 9 * MiB, WS_VMT = 11 * MiB, WS_WS = 13 * MiB;
constexpr size_t WS_WAIN = 14 * MiB, WS_WAOUT = 28 * MiB, WS_WGU0 = 36 * MiB, WS_WDN0 = 80 * MiB, WS_MIXB = 14 * MiB;
constexpr size_t WS_WMK = 102 * MiB, WS_WMV = 106 * MiB, WS_WGU1 = 110 * MiB, WS_WDN1 = 154 * MiB, WS_WBIN = 176 * MiB;
constexpr size_t WS_WUK = 183 * MiB, WS_WUV = 184 * MiB + 512 * 1024, WS_WUQ = 186 * MiB, WS_WBOUT = 189 * MiB;
constexpr size_t WS_HN = 197 * MiB;
constexpr size_t WS_ACT = 261 * MiB;
constexpr size_t WS_U = 261 * MiB, WS_VA = 309 * MiB, WS_MQ = 357 * MiB, WS_MIXA = 373 * MiB;
constexpr size_t WS_GOUT = 437 * MiB;
constexpr size_t WS_CKV = 261 * MiB, WS_ZQ = 277 * MiB, WS_KR = 293 * MiB, WS_MQB = 295 * MiB, WS_KN = 311 * MiB, WS_VT = 359 * MiB, WS_Q = 407 * MiB;
constexpr size_t WS_ST = 501 * MiB;
constexpr size_t WS_END = 504 * MiB;
constexpr int ST_VSUM = 0, ST_VSS = 16384 * 24;
constexpr int ST_G = 0;
constexpr int ST_CKV = 0, ST_CKVC = 16384 * 8, ST_Q = 2 * 16384 * 8;
constexpr int CTL_QUEUE = 0;
constexpr int CW_BAR = 1024;
constexpr size_t CTL_ZERO_BYTES = 65536;
constexpr size_t WS_HSS = 256 * 1024;

constexpr int LDS_BYTES = 147456;
constexpr int LDS_MISC = 131072;

struct Args { const float* in[24]; float* out; unsigned char* ws; int ph_lo, ph_hi; };

__device__ __forceinline__ float wave_sum(float v) {
#pragma unroll
    for (int o = 1; o < 64; o <<= 1) v += __shfl_xor(v, o);
    return v;
}
__device__ __forceinline__ unsigned pk2(float lo, float hi) { return pg8::cvt_pk_bf16(lo, hi); }
typedef float v2f_ __attribute__((ext_vector_type(2)));
typedef __bf16 v2bf_ __attribute__((ext_vector_type(2)));
__device__ __forceinline__ unsigned pk2b(float lo, float hi) { return __builtin_bit_cast(unsigned, __builtin_convertvector((v2f_){lo, hi}, v2bf_)); }
__device__ __forceinline__ float bf_lo(unsigned u) { return __uint_as_float(u << 16); }
__device__ __forceinline__ float bf_hi(unsigned u) { return __uint_as_float(u & 0xffff0000u); }
__device__ __forceinline__ void store8(bf16* p, v4f a, v4f b) { v4u w; w.x = pk2(a[0], a[1]); w.y = pk2(a[2], a[3]); w.z = pk2(b[0], b[1]); w.w = pk2(b[2], b[3]); *(v4u*)p = w; }
__device__ __forceinline__ float gelu_tanh(float x) {
    constexpr float K1 = -2.0f * LOG2E * 0.7978845608028654f, K2 = K1 * 0.044715f;
    const float y = x * __builtin_fmaf(K2, x * x, K1);
    return x * __builtin_amdgcn_rcpf(1.0f + __builtin_amdgcn_exp2f(y));
}
__device__ __forceinline__ float silu_mul(float g, float u) { return g * u * __builtin_amdgcn_rcpf(1.0f + __builtin_amdgcn_exp2f(-LOG2E * g)); }
__device__ __forceinline__ v4f gelu4(v4f v) { return (v4f){gelu_tanh(v[0]), gelu_tanh(v[1]), gelu_tanh(v[2]), gelu_tanh(v[3])}; }
__device__ __forceinline__ float sum4(v4f v) { return (v[0] + v[1]) + (v[2] + v[3]); }
__device__ __forceinline__ float ssq4(v4f v) { return (v[0] * v[0] + v[1] * v[1]) + (v[2] * v[2] + v[3] * v[3]); }

enum { EK_STORE = 0, EK_AIN = 1, EK_GATEUP = 2, EK_BIN = 3, EK_UQ = 4, EK_P9 = 5 };
constexpr int VT_CKV = (int)(WS_CKV >> 18), VT_WUK = (int)(WS_WUK >> 18), VT_WUV = (int)(WS_WUV >> 18), VT_ZQ = (int)(WS_ZQ >> 18), VT_WUQ = (int)(WS_WUQ >> 18);
static_assert((WS_CKV & 262143) == 0 && (WS_WUK & 262143) == 0 && (WS_WUV & 262143) == 0 && (WS_ZQ & 262143) == 0 && (WS_WUQ & 262143) == 0, "phase-9 operands sit on 256-KiB tile boundaries");
struct Epi {
    static constexpr bool PERM = true, AFTER_DRAIN = false;
    int kind, scale_mode  , accss, ldc;
    bf16* o0; const float* ssin; float inv_n; float* ss0; int nslots; int vt_nt; unsigned char* wsb;
    int pm_cached; LAS const float* lrs;
    __device__ __forceinline__ void operator()(const pg8::f32x4 (&acc)[2][2][4][2], const pg8::Unit& u, int wr_, int wc_, int fr_, int fq_) const {
        int tid_ = threadIdx.x; asm volatile("" : "+v"(tid_));
        const int wr = tid_ >> 8, wc = (tid_ >> 6) & 3, fr = tid_ & 15, fq = (tid_ >> 4) & 3;
        int kind_ = kind, scale_ = scale_mode, ldc_ = ldc, pm_ = __builtin_amdgcn_readfirstlane(u.pm), pn = __builtin_amdgcn_readfirstlane(u.pn);
        bf16* o0_ = o0; const float* ssin_ = ssin;
        if (kind == EK_P9) {
            if (pn >= VT_WUK && pn < VT_WUK + 6) { kind_ = EK_STORE; scale_ = 1; ldc_ = 1536; pn -= VT_WUK; pm_ -= VT_CKV; o0_ = (bf16*)(wsb + WS_KN); ssin_ = (const float*)(wsb + WS_ST) + ST_CKV; }
            else if (pn >= VT_WUQ && pn < VT_WUQ + 9) { kind_ = EK_UQ; pn -= VT_WUQ; pm_ -= VT_ZQ; o0_ = (bf16*)(wsb + WS_Q); ssin_ = (const float*)(wsb + WS_ST) + ST_Q; }
            else { kind_ = EK_STORE; scale_ = 2; ldc_ = NTOK; pn -= VT_CKV; pm_ -= VT_WUV; o0_ = (bf16*)(wsb + WS_VT); ssin_ = (const float*)(wsb + WS_ST) + ST_CKVC; }
        }
        const int row0 = pm_ * 256 + wr * 64 + fr;
        const int cl = wc * 32 + 8 * fq;
        if (kind_ == EK_STORE) {
            const int col0 = pn * 256 + cl;
            if (scale_ == 2) {
                v4f cs[2][2];
#pragma unroll
                for (int bj = 0; bj < 2; ++bj)
#pragma unroll
                    for (int n = 0; n < 2; ++n) { v4f t = *(const v4f*)(ssin_ + col0 + bj * 128 + 4 * n);
#pragma unroll
                        for (int sl = 1; sl < 8; ++sl) t += *(const v4f*)(ssin_ + sl * 16384 + col0 + bj * 128 + 4 * n);
                        cs[bj][n] = (v4f){__builtin_amdgcn_rsqf(t[0] * inv_n + EPS), __builtin_amdgcn_rsqf(t[1] * inv_n + EPS), __builtin_amdgcn_rsqf(t[2] * inv_n + EPS), __builtin_amdgcn_rsqf(t[3] * inv_n + EPS)}; }
#pragma unroll
                for (int ai = 0; ai < 2; ++ai)
#pragma unroll
                    for (int m = 0; m < 4; ++m) {
                        const int row = row0 + ai * 128 + m * 16;
#pragma unroll
                        for (int bj = 0; bj < 2; ++bj) { const int tk = col0 + bj * 128;
                            store8(o0_ + (unsigned)((((row >> 7) * 256 + (tk >> 6)) * 128 + (row & 127)) * 64 + (tk & 63)), acc[ai][bj][m][0] * cs[bj][0], acc[ai][bj][m][1] * cs[bj][1]); }
                    }
            } else {
                float rsv8[8];
#pragma unroll
                for (int i = 0; i < 8; ++i) { rsv8[i] = 1.f; if (scale_ == 1) { const int row = row0 + (i >> 2) * 128 + (i & 3) * 16; const v4f t0 = *(const v4f*)(ssin_ + (unsigned)(row * 8)), t1 = *(const v4f*)(ssin_ + (unsigned)(row * 8) + 4); rsv8[i] = __builtin_amdgcn_rsqf((sum4(t0) + sum4(t1)) * inv_n + EPS); } }
#pragma unroll
                for (int ai = 0; ai < 2; ++ai)
#pragma unroll
                    for (int m = 0; m < 4; ++m) {
                        const int row = row0 + ai * 128 + m * 16;
                        const float rs = rsv8[ai * 4 + m];
                        float q = 0.f;
#pragma unroll
                        for (int bj = 0; bj < 2; ++bj) {
                            const v4f v0 = acc[ai][bj][m][0] * rs, v1 = acc[ai][bj][m][1] * rs;
                            q += ssq4(v0) + ssq4(v1);
                            const int tk = col0 + bj * 128;
                            const unsigned off = vt_nt ? (unsigned)((((row >> 7) * vt_nt + (tk >> 6)) * 128 + (row & 127)) * 64 + (tk & 63)) : (unsigned)(row * ldc_ + tk);
                            store8(o0_ + off, v0, v1);
                        }
                        if (accss) { q += __shfl_xor(q, 16); q += __shfl_xor(q, 32); if (fq == 0) ss0[(unsigned)(row * nslots + pn * 4 + wc)] = q; }
                    }
            }
        } else if (kind_ == EK_AIN) {
            const int k3 = pn < 6 ? 0 : (pn < 12 ? 1 : 2);
            bf16* base = (bf16*)(wsb + (k3 == 0 ? WS_U : (k3 == 1 ? WS_VA : WS_MQ)));
            const int ld = k3 == 2 ? 512 : 1536;
            float* const ss0 = (float*)(wsb + WS_ST) + ST_VSUM; float* const ss1 = (float*)(wsb + WS_ST) + ST_VSS;
            const int col0 = (k3 == 0 ? pn : (k3 == 1 ? pn - 6 : pn - 12)) * 256 + cl;
#pragma unroll
            for (int ai = 0; ai < 2; ++ai)
#pragma unroll
                for (int m = 0; m < 4; ++m) {
                    const int row = row0 + ai * 128 + m * 16;
                    float s1 = 0.f, s2 = 0.f;
#pragma unroll
                    for (int bj = 0; bj < 2; ++bj) {
                        v4f v0 = acc[ai][bj][m][0], v1 = acc[ai][bj][m][1];
                        if (k3 < 2) { v0 = gelu4(v0); v1 = gelu4(v1); } else { v0 = v0 * QSCALE_MEM; v1 = v1 * QSCALE_MEM; }
                        s1 += sum4(v0) + sum4(v1); s2 += ssq4(v0) + ssq4(v1);
                        store8(base + (unsigned)(row * ld + col0) + bj * 128, v0, v1);
                    }
                    if (k3 == 1) { s1 += __shfl_xor(s1, 16); s1 += __shfl_xor(s1, 32); s2 += __shfl_xor(s2, 16); s2 += __shfl_xor(s2, 32);
                        if (fq == 0) { const unsigned si = (unsigned)(row * 24 + (pn - 6) * 4 + wc); ss0[si] = s1; ss1[si] = s2; } }
                }
        } else if (kind_ == EK_GATEUP) {
            const int col0 = pn * 128 + cl;
            float rsv[8];
            if (__builtin_amdgcn_readfirstlane(u.pm) == pm_cached) {
                const v4f r0 = *(LAS const v4f*)(lrs + (wr * 16 + fr) * 8), r1 = *(LAS const v4f*)(lrs + (wr * 16 + fr) * 8 + 4);
#pragma unroll
                for (int i = 0; i < 4; ++i) { rsv[i] = r0[i]; rsv[4 + i] = r1[i]; }
            } else { const float* hp = (const float*)(wsb + WS_HSS) + u.pm * 256 + (wr * 16 + fr) * 8; const v4f r0 = *(const v4f*)hp, r1 = *(const v4f*)(hp + 4);
#pragma unroll
              for (int i = 0; i < 4; ++i) { rsv[i] = __builtin_amdgcn_rsqf(r0[i] * (1.f / DM) + EPS); rsv[4 + i] = __builtin_amdgcn_rsqf(r1[i] * (1.f / DM) + EPS); } }
#pragma unroll
            for (int ai = 0; ai < 2; ++ai)
#pragma unroll
                for (int m = 0; m < 4; ++m) {
                    const int row = row0 + ai * 128 + m * 16;
                    const float rs = rsv[ai * 4 + m];
                    const float c1 = -LOG2E * rs, rs2 = rs * rs;
                    v4f a0, a1;
#pragma unroll
                    for (int e = 0; e < 4; ++e) {
                        const float g0_ = acc[ai][0][m][0][e], g1_ = acc[ai][0][m][1][e];
                        a0[e] = (g0_ * acc[ai][1][m][0][e]) * (rs2 * __builtin_amdgcn_rcpf(1.0f + __builtin_amdgcn_exp2f(g0_ * c1)));
                        a1[e] = (g1_ * acc[ai][1][m][1][e]) * (rs2 * __builtin_amdgcn_rcpf(1.0f + __builtin_amdgcn_exp2f(g1_ * c1))); }
                    store8(o0 + (unsigned)(row * DFF + col0), a0, a1);
                }
        } else if (kind_ == EK_BIN) {
            const float* const cosT = (const float*)(wsb + WS_COS); const float* const sinT = (const float*)(wsb + WS_SIN); bf16* const o2 = (bf16*)(wsb + WS_KR);
            float rsv[8];
            if (__builtin_amdgcn_readfirstlane(u.pm) == pm_cached) {
                const v4f r0 = *(LAS const v4f*)(lrs + (wr * 16 + fr) * 8), r1 = *(LAS const v4f*)(lrs + (wr * 16 + fr) * 8 + 4);
#pragma unroll
                for (int i = 0; i < 4; ++i) { rsv[i] = r0[i]; rsv[4 + i] = r1[i]; }
            } else { const float* hp = (const float*)(wsb + WS_HSS) + u.pm * 256 + (wr * 16 + fr) * 8; const v4f r0 = *(const v4f*)hp, r1 = *(const v4f*)(hp + 4);
#pragma unroll
              for (int i = 0; i < 4; ++i) { rsv[i] = __builtin_amdgcn_rsqf(r0[i] * (1.f / DM) + EPS); rsv[4 + i] = __builtin_amdgcn_rsqf(r1[i] * (1.f / DM) + EPS); } }
            if (pn == 2) {
                if (wc == 0) {
#pragma unroll
                    for (int ai = 0; ai < 2; ++ai)
#pragma unroll
                        for (int m = 0; m < 4; ++m) {
                            const int row = row0 + ai * 128 + m * 16;
                            const float rs = rsv[ai * 4 + m];
                            v4f y1[2], y2[2];
#pragma unroll
                            for (int n = 0; n < 2; ++n) { const v4f c = *(const v4f*)(cosT + (unsigned)(row * 32) + 8 * fq + 4 * n), s = *(const v4f*)(sinT + (unsigned)(row * 32) + 8 * fq + 4 * n);
                                const v4f x1 = acc[ai][0][m][n] * rs, x2 = acc[ai][1][m][n] * rs; y1[n] = x1 * c - x2 * s; y2[n] = x2 * c + x1 * s; }
                            store8(o2 + (unsigned)(row * 64) + 8 * fq, y1[0], y1[1]);
                            store8(o2 + (unsigned)(row * 64) + 32 + 8 * fq, y2[0], y2[1]);
                        }
                }
            } else {
                const int k3 = pn < 2 ? 0 : (pn < 5 ? 1 : 2);
                bf16* base = (bf16*)(wsb + (k3 == 0 ? WS_CKV : (k3 == 1 ? WS_ZQ : WS_MQB)));
                float* ssp = (float*)(wsb + WS_ST) + (k3 == 0 ? ST_CKV : ST_Q); float* const ssc = (float*)(wsb + WS_ST) + ST_CKVC;
                const int col0 = (k3 == 0 ? pn : (k3 == 1 ? pn - 3 : pn - 5)) * 256 + cl;
#pragma unroll
                for (int ai = 0; ai < 2; ++ai)
#pragma unroll
                    for (int m = 0; m < 4; ++m) {
                        const int row = row0 + ai * 128 + m * 16;
                        const float rs = rsv[ai * 4 + m] * (k3 == 2 ? QSCALE_MEM : 1.f);
                        float q = 0.f;
#pragma unroll
                        for (int bj = 0; bj < 2; ++bj) {
                            const v4f v0 = acc[ai][bj][m][0] * rs, v1 = acc[ai][bj][m][1] * rs;
                            q += ssq4(v0) + ssq4(v1);
                            store8(base + (unsigned)(row * 512 + col0) + bj * 128, v0, v1);
                        }
                        if (k3 < 2) { q += __shfl_xor(q, 16); q += __shfl_xor(q, 32); const int sl = (k3 == 0 ? pn : pn - 3) * 4 + wc;
                            if (fq == 0) { ssp[(unsigned)(row * 8 + sl)] = q; if (k3 == 0) ssc[(unsigned)(sl * 16384 + row)] = q; } }
                    }
            }
        } else {
            const float* const cosT = (const float*)(wsb + WS_COS); const float* const sinT = (const float*)(wsb + WS_SIN);
            float rsv8[8];
#pragma unroll
            for (int i = 0; i < 8; ++i) { const int row = row0 + (i >> 2) * 128 + (i & 3) * 16; const v4f t0 = *(const v4f*)(ssin_ + (unsigned)(row * 8)), t1 = *(const v4f*)(ssin_ + (unsigned)(row * 8) + 4);
                rsv8[i] = __builtin_amdgcn_rsqf((sum4(t0) + sum4(t1)) * inv_n + EPS) * QSCALE_MLA; }
            if (pn < 6) {
#pragma unroll
                for (int ai = 0; ai < 2; ++ai)
#pragma unroll
                    for (int m = 0; m < 4; ++m) {
                        const int row = row0 + ai * 128 + m * 16; const float rs = rsv8[ai * 4 + m];
                        bf16* qrow = o0_ + (unsigned)(row * 2304);
#pragma unroll
                        for (int bj = 0; bj < 2; ++bj) store8(qrow + (pn * 2 + bj) * 192 + cl, acc[ai][bj][m][0] * rs, acc[ai][bj][m][1] * rs);
                    }
            } else {
                const int head = 4 * (pn - 6) + wc;
#pragma unroll
                for (int h2 = 0; h2 < 4; ++h2) {
                    const int ai = h2 >> 1, mb = (h2 & 1) * 2;
                    v4f cc[2][2], sn[2][2];
#pragma unroll
                    for (int mm = 0; mm < 2; ++mm)
#pragma unroll
                        for (int n = 0; n < 2; ++n) { const int row = row0 + ai * 128 + (mb + mm) * 16; cc[mm][n] = *(const v4f*)(cosT + (unsigned)(row * 32) + 8 * fq + 4 * n); sn[mm][n] = *(const v4f*)(sinT + (unsigned)(row * 32) + 8 * fq + 4 * n); }
#pragma unroll
                    for (int mm = 0; mm < 2; ++mm) {
                        const int m = mb + mm;
                        const int row = row0 + ai * 128 + m * 16; const float rs = rsv8[ai * 4 + m];
                        bf16* qrow = o0_ + (unsigned)(row * 2304);
                        v4f y1[2], y2[2];
#pragma unroll
                        for (int n = 0; n < 2; ++n) { const v4f x1 = acc[ai][0][m][n] * rs, x2 = acc[ai][1][m][n] * rs; y1[n] = x1 * cc[mm][n] - x2 * sn[mm][n]; y2[n] = x2 * cc[mm][n] + x1 * sn[mm][n]; }
                        store8(qrow + head * 192 + 128 + 8 * fq, y1[0], y1[1]);
                        store8(qrow + head * 192 + 160 + 8 * fq, y2[0], y2[1]);
                    }
                }
            }
        }
    }
};

__device__ __forceinline__ void tr_load(float (&v)[32], const float* W, int ldw, int k0, int n0, int lane) {
    const float* src = W + (size_t)(k0 + (lane >> 5)) * ldw + n0 + (lane & 31);
#pragma unroll
    for (int i = 0; i < 32; ++i) v[i] = src[(size_t)(2 * i) * ldw];
}
__device__ __forceinline__ void tr_store(const float (&v)[32], int k0, const float* gain, bf16* dst, int K, LAS float* scr, int lane) {
    const int c = lane & 7;
    v4f g0 = (v4f){1.f, 1.f, 1.f, 1.f}, g1 = g0;
    if (gain) { g0 = *(const v4f*)(gain + k0 + 8 * c); g1 = *(const v4f*)(gain + k0 + 8 * c + 4); }
#pragma unroll
    for (int i = 0; i < 32; ++i) scr[(2 * i + (lane >> 5)) * 33 + (lane & 31)] = v[i];
    asm volatile("s_waitcnt lgkmcnt(0)" ::: "memory");
#pragma unroll
    for (int j = 0; j < 4; ++j) { const int n = (lane >> 3) + 8 * j; const LAS float* s = scr + (8 * c) * 33 + n;
        v4u o; o.x = pk2(s[0 * 33] * g0[0], s[1 * 33] * g0[1]); o.y = pk2(s[2 * 33] * g0[2], s[3 * 33] * g0[3]); o.z = pk2(s[4 * 33] * g1[0], s[5 * 33] * g1[1]); o.w = pk2(s[6 * 33] * g1[2], s[7 * 33] * g1[3]);
        *(v4u*)(dst + (size_t)n * K + k0 + 8 * c) = o; }
    asm volatile("s_waitcnt lgkmcnt(0)" ::: "memory");
}
constexpr int I_AIN = 32 * 112, I_MKV = 32 * 32, I_SQ = 32 * 64, I_GU = 32 * 176, I_DN = 88 * 64, I_KVA = 32 * 18, I_BIN = 32 * 32, I_UK = 8 * 48, I_UQ = 8 * 72;
constexpr int NITEMS = I_AIN + 2 * I_MKV + I_SQ + 4 * I_GU + 2 * I_DN + I_KVA + I_BIN + 2 * I_UK + I_UQ + I_SQ;
__device__ __forceinline__ void tr_decode(const Args& a, int it, const float*& W, int& ldw, int& k0, int& n0, const float*& gain, bf16*& dst, int& K) {
    unsigned char* ws = a.ws; const float* ng = a.in[3]; int r = it;
    if (r < I_AIN) { const int kb = r / 112, nb = r % 112; W = a.in[9]; ldw = 3584; k0 = 64 * kb; n0 = 32 * nb; gain = ng; dst = (bf16*)(ws + WS_WAIN) + (size_t)(32 * nb) * 2048; K = 2048; return; } r -= I_AIN;
    if (r < 2 * I_MKV) { const int l = r / I_MKV; r %= I_MKV; const int kb = r / 32, nb = r % 32; n0 = 32 * nb;
        dst = n0 < 512 ? (bf16*)(ws + WS_WMK) + (size_t)(l * 512 + n0) * 2048 : (bf16*)(ws + WS_WMV) + (size_t)(l * 512 + n0 - 512) * 2048;
        W = a.in[5] + (size_t)l * 2048 * 1024; ldw = 1024; k0 = 64 * kb; gain = a.in[4] + l * 2048; K = 2048; return; } r -= 2 * I_MKV;
    if (r < I_SQ) { const int kb = r / 64, nb = r % 64; W = a.in[14]; ldw = 2048; k0 = 64 * kb; n0 = 32 * nb; gain = nullptr; dst = (bf16*)(ws + WS_WAOUT) + (size_t)(32 * nb) * 2048; K = 2048; return; } r -= I_SQ;
    if (r < 4 * I_GU) { const int q = r / I_GU; r %= I_GU; const int l = q >> 1, isup = q & 1; const int kb = r / 176, nb = r % 176; n0 = 32 * nb;
        W = (isup ? a.in[7] : a.in[6]) + (size_t)l * 2048 * DFF; ldw = DFF; k0 = 64 * kb; gain = ng + (l * 4 + 2) * 2048; K = 2048;
        dst = (bf16*)(ws + (l ? WS_WGU1 : WS_WGU0)) + (size_t)(256 * (n0 / 128) + 128 * isup + (n0 % 128)) * 2048; return; } r -= 4 * I_GU;
    if (r < 2 * I_DN) { const int l = r / I_DN; r %= I_DN; const int kb = r / 64, nb = r % 64;
        W = a.in[8] + (size_t)l * DFF * 2048; ldw = 2048; k0 = 64 * kb; n0 = 32 * nb; gain = nullptr; dst = (bf16*)(ws + (l ? WS_WDN1 : WS_WDN0)) + (size_t)(32 * nb) * DFF; K = DFF; return; } r -= 2 * I_DN;
    if (r < I_KVA) { const int kb = r / 18, nb = r % 18; n0 = 32 * nb; const int drow = n0 < 512 ? n0 : (n0 == 512 ? 512 : 640);
        W = a.in[16]; ldw = 576; k0 = 64 * kb; gain = a.in[15]; dst = (bf16*)(ws + WS_WBIN) + (size_t)drow * 2048; K = 2048; return; } r -= I_KVA;
    if (r < I_BIN) { const int kb = r / 32, nb = r % 32; W = a.in[20]; ldw = 1024; k0 = 64 * kb; n0 = 32 * nb; gain = ng + 4 * 2048; dst = (bf16*)(ws + WS_WBIN) + (size_t)(768 + 32 * nb) * 2048; K = 2048; return; } r -= I_BIN;
    if (r < 2 * I_UK) { const int isv = r / I_UK; r %= I_UK; const int kb = r / 48, nb = r % 48;
        W = isv ? a.in[19] : a.in[18]; ldw = 1536; k0 = 64 * kb; n0 = 32 * nb; gain = a.in[17]; dst = (bf16*)(ws + (isv ? WS_WUV : WS_WUK)) + (size_t)(32 * nb) * 512; K = 512; return; } r -= 2 * I_UK;
    if (r < I_UQ) { const int kb = r / 72, nb = r % 72; n0 = 32 * nb; const int h = n0 / 192, d0 = n0 % 192;
        const int drow = d0 < 128 ? h * 128 + d0 : 1536 + 256 * (h >> 2) + 128 * ((d0 - 128) >> 5) + 32 * (h & 3);
        W = a.in[22]; ldw = 2304; k0 = 64 * kb; gain = a.in[21]; dst = (bf16*)(ws + WS_WUQ) + (size_t)drow * 512; K = 512; return; } r -= I_UQ;
    { const int kb = r / 64, nb = r % 64; W = a.in[23]; ldw = 2048; k0 = 64 * kb; n0 = 32 * nb; gain = nullptr; dst = (bf16*)(ws + WS_WBOUT) + (size_t)(32 * nb) * 2048; K = 2048; }
}
__device__ __forceinline__ void rms_row_bf16(const float* xrow, bf16* orow, int lane) {
    v4f v[8]; float s = 0.f;
#pragma unroll
    for (int j = 0; j < 4; ++j) { v[2 * j] = *(const v4f*)(xrow + 8 * (lane + 64 * j)); v[2 * j + 1] = *(const v4f*)(xrow + 8 * (lane + 64 * j) + 4); s += ssq4(v[2 * j]) + ssq4(v[2 * j + 1]); }
    const float rstd = __builtin_amdgcn_rsqf(wave_sum(s) * (1.f / DM) + EPS);
#pragma unroll
    for (int j = 0; j < 4; ++j) store8(orow + 8 * (lane + 64 * j), v[2 * j] * rstd, v[2 * j + 1] * rstd);
}

__device__ __forceinline__ void prologue(const Args& a, LAS unsigned char* lds) {
    int tid = threadIdx.x; asm volatile("" : "+v"(tid));
    const int lane = tid & 63, wave = __builtin_amdgcn_readfirstlane(tid >> 6);
    int G = gridDim.x; asm volatile("" : "+s"(G));
    const int gw = blockIdx.x * 8 + wave, NGW = G * 8, gt = blockIdx.x * 512 + tid, NGT = G * 512;
    unsigned char* ws = a.ws;
    for (int i = gt; i < 2 * 96 * 1024; i += NGT) { const int blk = i / (96 * 1024), r = i % (96 * 1024); ((unsigned*)(ws + WS_WBIN))[(size_t)(blk == 0 ? 544 : 672) * 1024 + r] = 0u; }
    { const float* wsrc = a.in[12]; bf16* wd = (bf16*)(ws + WS_WS);
      for (int i = gt; i < 12 * 128 * 128; i += NGT) { const int t = (i >> 7) & 127, s = i & 127; wd[i] = (bf16)(pk2(s <= t ? wsrc[i] : 0.f, 0.f) & 0xffffu); } }
    { const int* pos = (const int*)a.in[2]; float* ct = (float*)(ws + WS_COS); float* st = (float*)(ws + WS_SIN);
      for (int i = gt; i < NTOK * 32; i += NGT) { const int tok = i >> 5, k = i & 31;
          const double invf = (double)__builtin_amdgcn_exp2f(-(float)(2 * k) * (13.287712379549449f / 64.f));
          const double rev = (double)pos[tok] * invf * 0.15915494309189535; const float fr = (float)(rev - __builtin_floor(rev));
          ct[i] = __builtin_amdgcn_cosf(fr); st[i] = __builtin_amdgcn_sinf(fr); } }
    LAS float* scr = (LAS float*)(lds + wave * 16384);
    {
        float va[32], vb[32];
        const float *Wa, *Wb, *ga, *gb; int lda, ldb_, k0a, k0b, n0a, n0b, Ka, Kb2; bf16 *da, *db;
        int it = gw;
        if (it < NITEMS) { tr_decode(a, it, Wa, lda, k0a, n0a, ga, da, Ka); tr_load(va, Wa, lda, k0a, n0a, lane); }
        for (; it < NITEMS; it += 2 * NGW) {
            const int i2 = it + NGW; const bool h2 = i2 < NITEMS;
            if (h2) { tr_decode(a, i2, Wb, ldb_, k0b, n0b, gb, db, Kb2); tr_load(vb, Wb, ldb_, k0b, n0b, lane); }
            tr_store(va, k0a, ga, da, Ka, scr, lane);
            const int i3 = i2 + NGW;
            if (i3 < NITEMS) { tr_decode(a, i3, Wa, lda, k0a, n0a, ga, da, Ka); tr_load(va, Wa, lda, k0a, n0a, lane); }
            if (h2) tr_store(vb, k0b, gb, db, Kb2, scr, lane);
        }
    }
    for (int m = gw; m < NTOK; m += NGW) rms_row_bf16(a.in[0] + (size_t)m * DM, (bf16*)(ws + WS_HN) + (size_t)m * DM, lane);
    for (int m = gw; m < 1024; m += NGW) rms_row_bf16(a.in[1] + (size_t)m * DM, (bf16*)(ws + WS_MEMN) + (size_t)m * DM, lane);
}

__device__ __forceinline__ void rowpass(const float* hin32, bf16* hbf, const bf16* gout, const float* ss, const float* gain, float* hss, float* out32) {
    int tid_ = threadIdx.x; asm volatile("" : "+v"(tid_));
    const int lane = tid_ & 63, wave = __builtin_amdgcn_readfirstlane(tid_ >> 6), gw = blockIdx.x * 8 + wave, NGW = gridDim.x * 8;
    for (int m0 = gw; m0 < NTOK; m0 += 2 * NGW) {
        const int m1 = (m0 + NGW < NTOK) ? m0 + NGW : m0;
        float sp[2]; v4u g[2][4]; v4u hb16[2][4]; v4f hf[2][8];
#pragma unroll
        for (int r = 0; r < 2; ++r) { const int m = r ? m1 : m0;
            sp[r] = lane < 32 ? ss[(size_t)m * 32 + lane] : 0.f;
#pragma unroll
            for (int j = 0; j < 4; ++j) { const int c = 8 * (lane + 64 * j);
                g[r][j] = *(const v4u*)(gout + (size_t)m * DM + c);
                if (hin32) { hf[r][2 * j] = *(const v4f*)(hin32 + (size_t)m * DM + c); hf[r][2 * j + 1] = *(const v4f*)(hin32 + (size_t)m * DM + c + 4); }
                else hb16[r][j] = *(const v4u*)(hbf + (size_t)m * DM + c); } }
#pragma unroll
        for (int r = 0; r < 2; ++r) { const int m = r ? m1 : m0;
            const float rs = __builtin_amdgcn_rsqf(wave_sum(sp[r]) * (1.f / DM) + EPS);
            float s = 0.f;
#pragma unroll
            for (int j = 0; j < 4; ++j) { const int c = 8 * (lane + 64 * j);
                v4f h0, h1;
                if (hin32) { h0 = hf[r][2 * j]; h1 = hf[r][2 * j + 1]; }
                else { const v4u hv = hb16[r][j]; h0 = (v4f){bf_lo(hv.x), bf_hi(hv.x), bf_lo(hv.y), bf_hi(hv.y)}; h1 = (v4f){bf_lo(hv.z), bf_hi(hv.z), bf_lo(hv.w), bf_hi(hv.w)}; }
                const v4f g0 = *(const v4f*)(gain + c), g1 = *(const v4f*)(gain + c + 4);
                const v4u gg = g[r][j];
                const v4f a0 = (v4f){bf_lo(gg.x), bf_hi(gg.x), bf_lo(gg.y), bf_hi(gg.y)}, a1 = (v4f){bf_lo(gg.z), bf_hi(gg.z), bf_lo(gg.w), bf_hi(gg.w)};
                const v4f v0 = h0 + a0 * rs * g0, v1 = h1 + a1 * rs * g1;
                if (out32) { *(v4f*)(out32 + (size_t)m * DM + c) = v0; *(v4f*)(out32 + (size_t)m * DM + c + 4) = v1; }
                else { store8(hbf + (size_t)m * DM + c, v0, v1); s += ssq4(v0) + ssq4(v1); } }
            if (!out32) { const float t = wave_sum(s); const int rr = m & 255; if (lane == 0) hss[(m & ~255) + (((rr >> 6) & 1) * 16 + (rr & 15)) * 8 + (rr >> 7) * 4 + ((rr >> 4) & 3)] = t; } }
    }
}

__device__ __forceinline__ void gating_phase(const Args& a, LAS unsigned char* lds) {
    int tid = threadIdx.x; asm volatile("" : "+v"(tid));
    const int lane = tid & 63, w = __builtin_amdgcn_readfirstlane(tid >> 6);
    unsigned char* ws = a.ws;
    const bf16* U = (const bf16*)(ws + WS_U); const bf16* VA = (const bf16*)(ws + WS_VA); bf16* MIX = (bf16*)(ws + WS_MIXA);
    const bf16* WS_ = (const bf16*)(ws + WS_WS);
    const float* vsum = (const float*)(ws + WS_ST) + ST_VSUM; const float* vss = (const float*)(ws + WS_ST) + ST_VSS;
    LAS float* lst = (LAS float*)(lds + 36864);
    const float* lng = a.in[10]; const float* lnb = a.in[11]; const float* bs = a.in[13];
    constexpr int VP = 136;
    LAS bf16* vT = (LAS bf16*)lds;
    for (int unit = blockIdx.x; unit < 128 * 12; unit += gridDim.x) {
        const int n = unit / 12, g = unit % 12, T0 = 128 * n;
        if (tid < 128) { const float* p1 = vsum + (size_t)(T0 + tid) * 24; const float* p2 = vss + (size_t)(T0 + tid) * 24; float a1 = 0.f, a2 = 0.f;
#pragma unroll
            for (int k = 0; k < 6; ++k) { a1 += sum4(*(const v4f*)(p1 + 4 * k)); a2 += sum4(*(const v4f*)(p2 + 4 * k)); }
            const float mean = a1 * (1.f / TOKW), var = a2 * (1.f / TOKW) - mean * mean; lst[2 * tid] = mean; lst[2 * tid + 1] = __builtin_amdgcn_rsqf(var + EPS); }
        __syncthreads();
#pragma unroll
        for (int i = 0; i < 4; ++i) {
            const int c = tid + 512 * i, s = c & 127, c8 = c >> 7;
            const v4u raw = *(const v4u*)(VA + (size_t)(T0 + s) * TOKW + g * 128 + c8 * 8);
            const float mean = lst[2 * s], rstd = lst[2 * s + 1];
            const v4f g0 = *(const v4f*)(lng + g * 128 + c8 * 8), g1 = *(const v4f*)(lng + g * 128 + c8 * 8 + 4), b0 = *(const v4f*)(lnb + g * 128 + c8 * 8), b1 = *(const v4f*)(lnb + g * 128 + c8 * 8 + 4);
            const v4f x0 = (v4f){bf_lo(raw.x), bf_hi(raw.x), bf_lo(raw.y), bf_hi(raw.y)}, x1 = (v4f){bf_lo(raw.z), bf_hi(raw.z), bf_lo(raw.w), bf_hi(raw.w)};
            const v4f y0 = (x0 - mean) * rstd * g0 + b0, y1 = (x1 - mean) * rstd * g1 + b1;
            const unsigned p0 = pk2(y0[0], y0[1]), p1 = pk2(y0[2], y0[3]), p2 = pk2(y1[0], y1[1]), p3 = pk2(y1[2], y1[3]);
            LAS bf16* d = vT + (c8 * 8) * VP + s;
            d[0 * VP] = (bf16)(p0 & 0xffffu); d[1 * VP] = (bf16)(p0 >> 16); d[2 * VP] = (bf16)(p1 & 0xffffu); d[3 * VP] = (bf16)(p1 >> 16);
            d[4 * VP] = (bf16)(p2 & 0xffffu); d[5 * VP] = (bf16)(p2 >> 16); d[6 * VP] = (bf16)(p3 & 0xffffu); d[7 * VP] = (bf16)(p3 >> 16);
        }
        __syncthreads();
        const int t = 16 * w + (lane & 15), kq = lane >> 4;
        const bf16* wrow = WS_ + ((size_t)g * 128 + t) * 128 + 8 * kq;
        v8s wf[4];
#pragma unroll
        for (int ks = 0; ks < 4; ++ks) wf[ks] = *(const v8s*)(wrow + 32 * ks);
        const float bias = bs[g * 128 + t];
        const int nks = (w >> 1) + 1;
#pragma unroll
        for (int ibp = 0; ibp < 4; ++ibp) {
            const int ib0 = 2 * ibp;
            v4f acc0 = (v4f){0.f, 0.f, 0.f, 0.f}, acc1 = acc0;
#pragma unroll
            for (int ks = 0; ks < 4; ++ks) if (ks < nks) {
                const v8s af0 = *(const LAS v8s*)(vT + (16 * ib0 + (lane & 15)) * VP + 32 * ks + 8 * kq);
                const v8s af1 = *(const LAS v8s*)(vT + (16 * ib0 + 16 + (lane & 15)) * VP + 32 * ks + 8 * kq);
                acc0 = __builtin_amdgcn_mfma_f32_16x16x32_bf16(af0, wf[ks], acc0, 0, 0, 0);
                acc1 = __builtin_amdgcn_mfma_f32_16x16x32_bf16(af1, wf[ks], acc1, 0, 0, 0);
            }
            const size_t tok = (size_t)(T0 + t);
            const int cpos = g * 128 + 16 * (ib0 + (kq & 1)) + 4 * (kq & 2);
            const v4u ul = *(const v4u*)(U + tok * TOKW + cpos);
            unsigned ax = ul.x, ay = ul.y, bx = ul.z, by = ul.w;
            { const auto rx = __builtin_amdgcn_permlane16_swap(ax, bx, false, false); ax = rx[0]; bx = rx[1];
              const auto ry = __builtin_amdgcn_permlane16_swap(ay, by, false, false); ay = ry[0]; by = ry[1]; }
            unsigned ox0 = pk2b(bf_lo(ax) * (acc0[0] + bias), bf_hi(ax) * (acc0[1] + bias)), oy0 = pk2b(bf_lo(ay) * (acc0[2] + bias), bf_hi(ay) * (acc0[3] + bias));
            unsigned ox1 = pk2b(bf_lo(bx) * (acc1[0] + bias), bf_hi(bx) * (acc1[1] + bias)), oy1 = pk2b(bf_lo(by) * (acc1[2] + bias), bf_hi(by) * (acc1[3] + bias));
            { const auto rx = __builtin_amdgcn_permlane16_swap(ox0, ox1, false, false); ox0 = rx[0]; ox1 = rx[1];
              const auto ry = __builtin_amdgcn_permlane16_swap(oy0, oy1, false, false); oy0 = ry[0]; oy1 = ry[1]; }
            v4u ov; ov.x = ox0; ov.y = oy0; ov.z = ox1; ov.w = oy1;
            *(v4u*)(MIX + tok * DM + cpos) = ov;
        }
        __syncthreads();
    }
}

template <int DQK, bool CAUSAL>
__device__ __forceinline__ void attn_unit(LAS unsigned char* lds, const bf16* Qp, int qpitch, const bf16* Kp, int kpitch, const bf16* KRp,
                                          const bf16* VTp  , bf16* Op, int opitch, int ntiles, int q0) {
    constexpr int KP = DQK + 8, VP = 72, KBYTES = 64 * KP * 2, VBYTES = 128 * VP * 2, NS = DQK / 16;
    int tid = threadIdx.x; asm volatile("" : "+v"(tid));
    const int lane = tid & 63, w = __builtin_amdgcn_readfirstlane(tid >> 6), r = lane & 31, hh = lane >> 5;
    LAS unsigned char* Kb = lds; LAS unsigned char* Vb = lds + 2 * KBYTES;
    v8s qf[NS];
    { const bf16* qrow = Qp + (size_t)(32 * w + r) * qpitch + 8 * hh;
#pragma unroll
      for (int s = 0; s < NS; ++s) qf[s] = *(const v8s*)(qrow + 16 * s); }
    v16f o[4];
#pragma unroll
    for (int i = 0; i < 4; ++i)
#pragma unroll
        for (int j = 0; j < 16; ++j) o[i][j] = 0.f;
    float m_ref = 0.f, l_run = 0.f;
    v4u kreg[3], vreg[2];
    const int kkey = tid >> 4, kc8 = tid & 15;
    const int rkey = tid >> 3, rc8 = tid & 7;
    const int vdv = tid >> 3, vkc = tid & 7;
#define ATT_LOAD(t) do { \
        _Pragma("unroll") for (int i = 0; i < 2; ++i) kreg[i] = *(const v4u*)(Kp + (size_t)((t) * 64 + kkey + 32 * i) * kpitch + kc8 * 8); \
        if (DQK == 192) kreg[2] = *(const v4u*)(KRp + (size_t)((t) * 64 + rkey) * 64 + rc8 * 8); \
        _Pragma("unroll") for (int i = 0; i < 2; ++i) vreg[i] = *(const v4u*)(VTp + (size_t)(t) * 8192 + (tid + 512 * i) * 8); } while (0)
#define ATT_WRITE(b) do { \
        _Pragma("unroll") for (int i = 0; i < 2; ++i) *(LAS v4u*)(Kb + (b) * KBYTES + (kkey + 32 * i) * (KP * 2) + kc8 * 16) = kreg[i]; \
        if (DQK == 192) *(LAS v4u*)(Kb + (b) * KBYTES + rkey * (KP * 2) + 256 + rc8 * 16) = kreg[2]; \
        _Pragma("unroll") for (int i = 0; i < 2; ++i) *(LAS v4u*)(Vb + (b) * VBYTES + (vdv + 64 * i) * (VP * 2) + vkc * 16) = vreg[i]; } while (0)
    ATT_LOAD(0); ATT_WRITE(0);
    if (ntiles > 1) ATT_LOAD(1);
    asm volatile("s_waitcnt lgkmcnt(0)" ::: "memory"); __builtin_amdgcn_s_barrier(); asm volatile("" ::: "memory");
    for (int t = 0; t < ntiles; ++t) {
        const int b = t & 1;
        if (t + 1 < ntiles) { ATT_WRITE(b ^ 1); if (t + 2 < ntiles) ATT_LOAD(t + 2); }
        const bool active = !CAUSAL || (t * 64 <= q0 + 32 * w + 31);
        if (active) {
            constexpr int BS = NS / 4;
            const LAS unsigned char* kp0 = Kb + b * KBYTES + r * (KP * 2) + hh * 16;
            const LAS unsigned char* vp0 = Vb + b * VBYTES + r * (VP * 2) + hh * 8;
            const bool need_mask = CAUSAL && (t * 64 + 63 > q0 + 32 * w);
            const int qi = q0 + 32 * w + r - t * 64 - 4 * hh;
            v16f sa0, sa1;
            const v16f zero16 = {0.f, 0.f, 0.f, 0.f, 0.f, 0.f, 0.f, 0.f, 0.f, 0.f, 0.f, 0.f, 0.f, 0.f, 0.f, 0.f};
            v8s kx[2][BS], vx[2][2];
            unsigned pw0[8], pw1[8];
            float rs0 = 0.f, rs1 = 0.f;
#define ATT_SB() __builtin_amdgcn_sched_barrier(0)
#define ATT_LDK(dst, kb, q) do { _Pragma("unroll") for (int i = 0; i < BS; ++i) dst[i] = *(const LAS v8s*)(kp0 + (kb) * (32 * KP * 2) + ((q) * BS + i) * 32); } while (0)
#define ATT_MMK(accv, src, q) do { __builtin_amdgcn_s_setprio(1); _Pragma("unroll") for (int i = 0; i < BS; ++i) accv = __builtin_amdgcn_mfma_f32_32x32x16_bf16(src[i], qf[(q) * BS + i], ((q) == 0 && i == 0) ? zero16 : accv, 0, 0, 0); __builtin_amdgcn_s_setprio(0); } while (0)
#define ATT_EXPC(sav, c, rsv_, pw) do { const float p0_ = __builtin_amdgcn_exp2f(sav[4 * (c)] - m_ref), p1_ = __builtin_amdgcn_exp2f(sav[4 * (c) + 1] - m_ref), p2_ = __builtin_amdgcn_exp2f(sav[4 * (c) + 2] - m_ref), p3_ = __builtin_amdgcn_exp2f(sav[4 * (c) + 3] - m_ref); \
                rsv_ += (p0_ + p1_) + (p2_ + p3_); pw[2 * (c)] = pk2b(p0_, p1_); pw[2 * (c) + 1] = pk2b(p2_, p3_); } while (0)
#define ATT_MASK(sav, kb) do { if (need_mask) { _Pragma("unroll") for (int j = 0; j < 16; ++j) { if (32 * (kb) + (j & 3) + 8 * (j >> 2) > qi) sav[j] = -1e30f; } } } while (0)
#define ATT_LDV(dst, db, pr) do { _Pragma("unroll") for (int i = 0; i < 2; ++i) { const int s_ = (pr) * 2 + i; const v2u lo = *(const LAS v2u*)(vp0 + (db) * (32 * VP * 2) + s_ * 32), hi = *(const LAS v2u*)(vp0 + (db) * (32 * VP * 2) + s_ * 32 + 16); \
                v4u av; av.x = lo.x; av.y = lo.y; av.z = hi.x; av.w = hi.y; dst[i] = __builtin_bit_cast(v8s, av); } } while (0)
#define ATT_MMV(db, src, pwv) do { _Pragma("unroll") for (int i = 0; i < 2; ++i) { v4u pv_; pv_.x = pwv[4 * i]; pv_.y = pwv[4 * i + 1]; pv_.z = pwv[4 * i + 2]; pv_.w = pwv[4 * i + 3]; \
                __builtin_amdgcn_s_setprio(1); o[db] = __builtin_amdgcn_mfma_f32_32x32x16_bf16(src[i], __builtin_bit_cast(v8s, pv_), o[db], 0, 0, 0); __builtin_amdgcn_s_setprio(0); } } while (0)
#define ATT_FIX(sav, other_too, forced, rsv_, pw) do { if (__builtin_amdgcn_ballot_w64((forced) || !(rsv_ < 1e12f)) != 0ull) { \
                float mx = sav[0]; _Pragma("unroll") for (int j = 1; j < 16; ++j) mx = fmaxf(mx, sav[j]); mx = fmaxf(mx, __shfl_xor(mx, 32)) - m_ref; \
                const float delta = (forced) ? mx : fmaxf(mx, 0.f); const float alpha = (forced) ? 1.f : __builtin_amdgcn_exp2f(-delta); \
                m_ref += delta; \
                l_run *= alpha; _Pragma("unroll") for (int i = 0; i < 4; ++i) o[i] = o[i] * alpha; \
                rsv_ = 0.f; ATT_EXPC(sav, 0, rsv_, pw); ATT_EXPC(sav, 1, rsv_, pw); ATT_EXPC(sav, 2, rsv_, pw); ATT_EXPC(sav, 3, rsv_, pw); } } while (0)
            ATT_LDK(kx[0], 0, 0); ATT_SB();
            ATT_LDK(kx[1], 0, 1); ATT_SB(); ATT_MMK(sa0, kx[0], 0); ATT_SB();
            ATT_LDK(kx[0], 0, 2); ATT_SB(); ATT_MMK(sa0, kx[1], 1); ATT_SB();
            ATT_LDK(kx[1], 0, 3); ATT_SB(); ATT_MMK(sa0, kx[0], 2); ATT_SB();
            ATT_LDK(kx[0], 1, 0); ATT_SB(); ATT_MMK(sa0, kx[1], 3); ATT_SB();
            ATT_MASK(sa0, 0); ATT_SB();
            ATT_LDK(kx[1], 1, 1); ATT_SB(); ATT_MMK(sa1, kx[0], 0); ATT_EXPC(sa0, 0, rs0, pw0); ATT_SB();
            ATT_LDK(kx[0], 1, 2); ATT_SB(); ATT_MMK(sa1, kx[1], 1); ATT_EXPC(sa0, 1, rs0, pw0); ATT_SB();
            ATT_LDK(kx[1], 1, 3); ATT_SB(); ATT_MMK(sa1, kx[0], 2); ATT_EXPC(sa0, 2, rs0, pw0); ATT_SB();
            ATT_LDV(vx[0], 0, 0); ATT_SB(); ATT_MMK(sa1, kx[1], 3); ATT_EXPC(sa0, 3, rs0, pw0); ATT_SB();
            ATT_MASK(sa1, 1);
            ATT_FIX(sa0, true, t == 0, rs0, pw0);
            l_run += rs0; ATT_SB();
            ATT_LDV(vx[1], 1, 0); ATT_SB(); ATT_MMV(0, vx[0], pw0); ATT_EXPC(sa1, 0, rs1, pw1); ATT_SB();
            ATT_LDV(vx[0], 2, 0); ATT_SB(); ATT_MMV(1, vx[1], pw0); ATT_EXPC(sa1, 1, rs1, pw1); ATT_SB();
            ATT_LDV(vx[1], 3, 0); ATT_SB(); ATT_MMV(2, vx[0], pw0); ATT_EXPC(sa1, 2, rs1, pw1); ATT_SB();
            ATT_LDV(vx[0], 0, 1); ATT_SB(); ATT_MMV(3, vx[1], pw0); ATT_EXPC(sa1, 3, rs1, pw1); ATT_SB();
            ATT_FIX(sa1, false, false, rs1, pw1);
            l_run += rs1; ATT_SB();
            ATT_LDV(vx[1], 1, 1); ATT_SB(); ATT_MMV(0, vx[0], pw1); ATT_SB();
            ATT_LDV(vx[0], 2, 1); ATT_SB(); ATT_MMV(1, vx[1], pw1); ATT_SB();
            ATT_LDV(vx[1], 3, 1); ATT_SB(); ATT_MMV(2, vx[0], pw1); ATT_SB();
            ATT_MMV(3, vx[1], pw1); ATT_SB();
#undef ATT_SB
#undef ATT_LDK
#undef ATT_MMK
#undef ATT_EXPC
#undef ATT_MASK
#undef ATT_LDV
#undef ATT_MMV
#undef ATT_FIX
        }
        asm volatile("s_waitcnt lgkmcnt(0)" ::: "memory"); __builtin_amdgcn_s_barrier(); asm volatile("" ::: "memory");
    }
#undef ATT_LOAD
#undef ATT_WRITE
    const float ltot = l_run + __shfl_xor(l_run, 32);
    const float inv = 1.0f / ltot;
    bf16* orow = Op + (size_t)(32 * w + r) * opitch + 8 * hh;
#pragma unroll
    for (int db = 0; db < 4; ++db)
#pragma unroll
        for (int gp = 0; gp < 2; ++gp) {
            const int g = 2 * gp;
            unsigned ax = pk2b(o[db][4 * g] * inv, o[db][4 * g + 1] * inv), ay = pk2b(o[db][4 * g + 2] * inv, o[db][4 * g + 3] * inv);
            unsigned bx = pk2b(o[db][4 * g + 4] * inv, o[db][4 * g + 5] * inv), by = pk2b(o[db][4 * g + 6] * inv, o[db][4 * g + 7] * inv);
            const auto rx = __builtin_amdgcn_permlane32_swap(ax, bx, false, false); ax = rx[0]; bx = rx[1];
            const auto ry = __builtin_amdgcn_permlane32_swap(ay, by, false, false); ay = ry[0]; by = ry[1];
            v4u ov; ov.x = ax; ov.y = ay; ov.z = bx; ov.w = by;
            *(v4u*)(orow + 32 * db + 16 * gp) = ov;
        }
}

__device__ __forceinline__ unsigned my_xcc_id() { return (unsigned)__builtin_amdgcn_s_getreg((3 << 11) | 20) & 7u; }
__device__ __forceinline__ void attn_phase(const Args& a, LAS unsigned char* lds, bool layerB, int rep) {
    unsigned char* ws = a.ws;
    unsigned* qbase = (unsigned*)(ws + WS_CTL) + CTL_QUEUE + (layerB ? 128 : 0) + 256 * rep;
    volatile LAS unsigned* slot = (volatile LAS unsigned*)(lds + LDS_MISC);
    const int ncausal = layerB ? 96 : 0, total = ncausal + 32;
    bf16* MIX = (bf16*)(ws + (layerB ? WS_MIXB : WS_MIXA));
    const bf16* MQ = (const bf16*)(ws + (layerB ? WS_MQB : WS_MQ));
    const unsigned myx = my_xcc_id();
    for (int k = 0; k < 8; ++k) {
        const int x = (int)((myx + k) & 7u);
        unsigned* qctr = qbase + 16 * x;
        for (;;) {
            __syncthreads();
            if (threadIdx.x == 0) slot[0] = atomicAdd(qctr, 1u);
            __syncthreads();
            const int idx = (int)slot[0];
            if (idx >= total) break;
            if (idx < ncausal) {
                const int qb = 15 - idx / 6, bh = x + 8 * (idx % 6), b = bh / 12, h = bh % 12;
                const size_t tok0 = (size_t)b * SEQ;
                attn_unit<192, true>(lds, (const bf16*)(ws + WS_Q) + (tok0 + 256 * qb) * 2304 + h * 192, 2304,
                                     (const bf16*)(ws + WS_KN) + tok0 * 1536 + h * 128, 1536, (const bf16*)(ws + WS_KR) + tok0 * 64,
                                     (const bf16*)(ws + WS_VT) + (size_t)(h * 256 + b * 64) * 8192,
                                     MIX + (tok0 + 256 * qb) * DM + h * 128, DM, 4 * (qb + 1), 256 * qb);
            } else {
                const int mi = x * 32 + (idx - ncausal), qblk = mi >> 2, h = mi & 3, b = qblk >> 4, l = layerB ? 1 : 0;
                const size_t row0 = (size_t)qblk * 256;
                attn_unit<128, false>(lds, MQ + row0 * 512 + h * 128, 512,
                                      (const bf16*)(ws + WS_KMEM) + (size_t)(b * 256) * 1024 + l * 512 + h * 128, 1024, nullptr,
                                      (const bf16*)(ws + WS_VMT) + (size_t)((l * 4 + h) * 16 + b * 4) * 8192,
                                      MIX + row0 * DM + TOKW + h * 128, DM, 4, 0);
            }
        }
    }
}

#define XB_TMO      128
#define XB_XCNT(j)  (256  + 64 * (j))
#define XB_XSUB(j)  (1280 + 64 * (j))
#define XB_XGEN(j)  (2304 + 64 * (j))
#define XB_TOP      3328
#define XB_TOPGEN   3392
#define XCD_BAR_WORDS 3456
#define XB_SPIN_CAP (1u << 18)

__device__ __forceinline__ unsigned xb_ld(unsigned* p)              { return __hip_atomic_load(p, __ATOMIC_RELAXED, __HIP_MEMORY_SCOPE_AGENT); }
__device__ __forceinline__ unsigned xb_add(unsigned* p, unsigned v) { return __hip_atomic_fetch_add(p, v, __ATOMIC_RELAXED, __HIP_MEMORY_SCOPE_AGENT); }
__device__ __forceinline__ unsigned xb_xcc_id() { return (unsigned)__builtin_amdgcn_s_getreg((3 << 11) | 20) & 0xFu; }
#define XB_SPIN(cond, bar) do { unsigned _sp = 0; while (cond) { __builtin_amdgcn_s_sleep(1); \
    if ((++_sp & 255u) == 0u) { if (xb_ld(&(bar)[XB_TMO])) break; if (_sp > XB_SPIN_CAP) { atomicAdd(&(bar)[XB_TMO], 1u); break; } } } } while (0)

struct XcdBarrier {
    unsigned* bar; unsigned x;
    volatile LAS unsigned* st;
};

__device__ __forceinline__ XcdBarrier xcd_barrier_post(unsigned* bar, volatile LAS unsigned* st) {
    XcdBarrier b; b.bar = bar; b.x = xb_xcc_id(); b.st = st;
    if (threadIdx.x == 0) (void)xb_add(&bar[XB_XCNT(b.x)], 1u);
    return b;
}
__device__ __forceinline__ void xcd_barrier_complete(unsigned* bar, unsigned x, unsigned& nloc, unsigned& nx) {
    const unsigned G = gridDim.x * gridDim.y * gridDim.z;
    unsigned sum, cnt, mine, sp = 0u;
    for (;;) {
        sum = 0u; cnt = 0u; mine = 0u;
#pragma unroll
        for (unsigned j = 0; j < 16; ++j) { const unsigned c = xb_ld(&bar[XB_XCNT(j)]); sum += c; cnt += (c > 0u) ? 1u : 0u; mine = (j == x) ? c : mine; }
        if (sum == G) break;
        __builtin_amdgcn_s_sleep(1);
        if ((++sp & 255u) == 0u) { if (xb_ld(&bar[XB_TMO])) break; if (sp > XB_SPIN_CAP) { atomicAdd(&bar[XB_TMO], 1u); break; } }
    }
    nloc = mine > 0u ? mine : 1u; nx = cnt > 0u ? cnt : 1u;
}

__device__ __forceinline__ void xcd_barrier(const XcdBarrier& b) {
    asm volatile("s_waitcnt vmcnt(0)" ::: "memory");
    __syncthreads();
    if (threadIdx.x == 0) {
        unsigned* bar = b.bar;
        __builtin_amdgcn_s_waitcnt(0);
        unsigned nloc = b.st[0], nx = b.st[1];
        if (nloc == 0u) { xcd_barrier_complete(bar, b.x, nloc, nx); b.st[0] = nloc; b.st[1] = nx; }
        const unsigned old = xb_add(&bar[XB_XSUB(b.x)], 1u);
        const unsigned gen = old / nloc;
        if (old + 1u == (gen + 1u) * nloc) {
            __builtin_amdgcn_fence(__ATOMIC_RELEASE, "agent");
            asm volatile("s_waitcnt vmcnt(0)" ::: "memory");
            const unsigned og = xb_add(&bar[XB_TOP], 1u);
            const unsigned tg = og / nx;
            if (og + 1u == (tg + 1u) * nx) xb_add(&bar[XB_TOPGEN], 1u);
            else XB_SPIN(xb_ld(&bar[XB_TOPGEN]) == tg, bar);
            __builtin_amdgcn_fence(__ATOMIC_ACQUIRE, "agent");
            xb_add(&bar[XB_XGEN(b.x)], 1u);
            asm volatile("s_waitcnt vmcnt(0)" ::: "memory");
        } else {
            XB_SPIN(xb_ld(&bar[XB_XGEN(b.x)]) == gen, bar);
            __builtin_amdgcn_fence(__ATOMIC_ACQUIRE, "agent");
            asm volatile("s_waitcnt vmcnt(0)" ::: "memory");
        }
    }
    __syncthreads();
}

__device__ __forceinline__ void tile_of(int nM, int nN, int wg, pg8::Unit& u) {
    const int nwg = nM * nN, q = nwg / 8, r = nwg % 8, xcd = wg % 8, off = wg / 8;
    wg = (xcd < r ? xcd * (q + 1) : r * (q + 1) + (xcd - r) * q) + off;
    const int nig = 8 * nN, gid = wg / nig, fm = gid * 8, gsz = (nM - fm) < 8 ? (nM - fm) : 8;
    u.pm = fm + ((wg % nig) % gsz); u.pn = (wg % nig) / gsz;
}
struct Order {
    pg8::StaticOrder s; int mode, G, c;
    __device__ __forceinline__ bool next(int i, pg8::Unit& u) const {
        if (mode == 0) return s.next(i, u);
        const int L = i * G + c;
        if (L < 384) { tile_of(64, 6, L, u); u.pm += VT_CKV; u.pn += VT_WUK; return true; }
        if (L < 768) { tile_of(6, 64, L - 384, u); u.pm += VT_WUV; u.pn += VT_CKV; return true; }
        if (L < 1344) { tile_of(64, 9, L - 768, u); u.pm += VT_ZQ; u.pn += VT_WUQ; return true; }
        return false;
    }
    __device__ __forceinline__ void a_ready(const pg8::Unit&) const {}
    __device__ __forceinline__ void done(const pg8::Unit&) const {}
};

__device__ __forceinline__ bool gemm_job(const Args& a, int p, int j, pg8::Gemm& g, Epi& E, int& rot) {
    unsigned char* ws = a.ws; float* ctl = (float*)(ws + WS_ST);
    E.kind = EK_STORE; E.scale_mode = 0; E.accss = 0; E.ldc = DM; E.o0 = nullptr; E.ssin = nullptr; E.inv_n = 0.f; E.ss0 = nullptr; E.nslots = 32; E.vt_nt = 0; E.wsb = ws; E.pm_cached = -1; E.lrs = nullptr; rot = 0;
#define BF(off) ((bf16*)(ws + (off)))
    switch (p) {
    case 1:
        if (j == 0) { g = pg8::Gemm{BF(WS_HN), BF(WS_WAIN), NTOK, 3584, 2048}; E.kind = EK_AIN; return true; }
        if (j == 1) { g = pg8::Gemm{BF(WS_MEMN), BF(WS_WMK), 1024, 1024, 2048}; E.o0 = BF(WS_KMEM); E.ldc = 1024; rot = 128; return true; }
        if (j == 2) { g = pg8::Gemm{BF(WS_WMV), BF(WS_MEMN), 1024, 1024, 2048}; E.o0 = BF(WS_VMT); E.ldc = 1024; E.vt_nt = 16; rot = 112; return true; }
        return false;
    case 3: case 11:
        if (j == 0) { g = pg8::Gemm{BF(p == 3 ? WS_MIXA : WS_MIXB), BF(p == 3 ? WS_WAOUT : WS_WBOUT), NTOK, DM, DM}; E.o0 = BF(WS_GOUT); E.accss = 1; E.ss0 = ctl + ST_G; return true; }
        return false;
    case 5: case 13:
        if (j == 0) { g = pg8::Gemm{BF(WS_HN), BF(p == 13 ? WS_WGU1 : WS_WGU0), NTOK, 11264, 2048}; E.kind = EK_GATEUP; E.o0 = BF(WS_ACT); return true; }
        return false;
    case 6: case 14:
        if (j == 0) { g = pg8::Gemm{BF(WS_ACT), BF(p == 14 ? WS_WDN1 : WS_WDN0), NTOK, DM, DFF}; E.o0 = BF(WS_GOUT); E.accss = 1; E.ss0 = ctl + ST_G; return true; }
        return false;
    case 8:
        if (j == 0) { g = pg8::Gemm{BF(WS_HN), BF(WS_WBIN), NTOK, 1792, 2048}; E.kind = EK_BIN; return true; }
        return false;
    case 9:
        if (j == 0) { g = pg8::Gemm{BF(0), BF(0), 256, 256, 512}; E.kind = EK_P9; E.inv_n = 1.f / 512.f; rot = -1; return true; }
        return false;
    default: return false;
    }
#undef BF
}

#ifndef PROBE_REP
#define PROBE_REP (-1)
#endif
__global__ void __launch_bounds__(512, 2) yoco_fwd(Args a) {
    extern __shared__ __attribute__((aligned(16))) unsigned char lds_raw[];
    LAS unsigned char* lds = (LAS unsigned char*)lds_raw;
    cg::grid_group grid = cg::this_grid();
    unsigned char* ws = a.ws; const float* ng = a.in[3];
    volatile LAS unsigned* misc = (volatile LAS unsigned*)(lds + LDS_MISC);
    if (threadIdx.x < 16) misc[threadIdx.x] = 0u;
    __syncthreads();
    XcdBarrier bar = xcd_barrier_post((unsigned*)(ws + WS_CTL) + CW_BAR, misc + 8);
    for (int p = a.ph_lo; p < a.ph_hi; ++p) {
        const int nrep = (p == PROBE_REP) ? 2 : 1;
        for (int rp = 0; rp < nrep; ++rp) {
            if (rp) xcd_barrier(bar);
            if (p == 0) prologue(a, lds);
            else if (p == 2 || p == 10) { if (p == 2) gating_phase(a, lds); attn_phase(a, lds, p == 10, rp); }
            else if (p == 4 || p == 7 || p == 12 || p == 15) {
                const float* ss = (const float*)(ws + WS_ST) + ST_G;
                const float* gain = ng + (p == 4 ? 1 : (p == 7 ? 3 : (p == 12 ? 5 : 7))) * 2048;
                rowpass(p == 4 ? a.in[0] : nullptr, (bf16*)(ws + WS_HN), (const bf16*)(ws + WS_GOUT), ss, gain, (float*)(ws + WS_HSS), p == 15 ? a.out : nullptr);
            } else {
                for (int j = 0;; ++j) {
                    pg8::Gemm g; Epi E; int rot;
                    if (!gemm_job(a, p, j, g, E, rot)) break;
                    Order S; S.mode = rot < 0 ? 1 : 0; S.G = (int)gridDim.x; S.c = (int)blockIdx.x; if (rot < 0) rot = 0;
                    S.s.init(g.M, g.N, (int)gridDim.x, (int)((blockIdx.x + rot) % gridDim.x));
                    if (E.kind == EK_GATEUP || E.kind == EK_BIN) {
                        pg8::Unit u0; LAS float* lrs = (LAS float*)(lds + LDS_MISC + 1024);
                        if (S.next(0, u0)) { if (threadIdx.x < 256) lrs[threadIdx.x] = __builtin_amdgcn_rsqf(((const float*)(ws + WS_HSS))[u0.pm * 256 + threadIdx.x] * (1.f / DM) + EPS); E.pm_cached = u0.pm; E.lrs = lrs; }
                        __syncthreads();
                    }
                    pg8::gemm_phase<Epi, Order, true, true>(lds, g, S, E);
                }
            }
        }
        if (p + 1 < a.ph_hi) { if (p == 0) grid.sync(); else xcd_barrier(bar); }
    }
}

extern "C" void kernel_launch(void* const* d_in, const int* in_sizes, int n_in, void* d_out, int out_size, void* d_ws, size_t ws_size, hipStream_t stream) {
    static int grid = 0;
    if (grid == 0) {
        if (n_in != 24 || out_size != NTOK * DM || ws_size < WS_END) { fprintf(stderr, "kernel_launch: unexpected shapes (n_in %d out %d ws %zu)\n", n_in, out_size, ws_size); grid = -1; return; }
        int dev = 0, cus = 0, per_cu = 0;
        hipGetDevice(&dev); hipDeviceGetAttribute(&cus, hipDeviceAttributeMultiprocessorCount, dev);
        if (hipFuncSetAttribute((const void*)yoco_fwd, hipFuncAttributeMaxDynamicSharedMemorySize, LDS_BYTES) != hipSuccess) { fprintf(stderr, "kernel_launch: hipFuncSetAttribute failed\n"); grid = -1; return; }
        hipOccupancyMaxActiveBlocksPerMultiprocessor(&per_cu, (const void*)yoco_fwd, 512, LDS_BYTES);
        (void)hipGetLastError();
        if (per_cu < 1) per_cu = 1;
        grid = cus * per_cu;
        fprintf(stderr, "kernel_launch: grid %d (%d CUs x %d)\n", grid, cus, per_cu);
    }
    if (grid < 0) return;
    if (hipMemsetAsync((char*)d_ws + WS_CTL, 0, CTL_ZERO_BYTES, stream) != hipSuccess) { fprintf(stderr, "kernel_launch: memset failed\n"); return; }
    Args a{};
    for (int i = 0; i < 24; ++i) a.in[i] = (const float*)d_in[i];
    a.out = (float*)d_out; a.ws = (unsigned char*)d_ws;
#ifndef N_CUTS
    a.ph_lo = 0; a.ph_hi = 16;
    void* args[] = {&a};
    hipError_t e = hipLaunchCooperativeKernel((const void*)yoco_fwd, dim3(grid), dim3(512), args, LDS_BYTES, stream);
    if (e != hipSuccess) fprintf(stderr, "cooperative launch failed: %s (grid %d)\n", hipGetErrorString(e), grid);
#else
    for (int p = 0; p < 16; ++p) { a.ph_lo = p; a.ph_hi = p + 1; void* args[] = {&a};
        hipError_t e = hipLaunchCooperativeKernel((const void*)yoco_fwd, dim3(grid), dim3(512), args, LDS_BYTES, stream);
        if (e != hipSuccess) { fprintf(stderr, "launch %d failed: %s\n", p, hipGetErrorString(e)); break; } }
#endif
}
```

```cpp
#include <hip/hip_runtime.h>
#include <hip/hip_cooperative_groups.h>
#include <cstdio>
#include <cstdint>
namespace cg = cooperative_groups;
namespace pg8 {
#define PG8_LAS __attribute__((address_space(3)))
typedef unsigned short bf16_t;
typedef short bf16x8 __attribute__((ext_vector_type(8)));
typedef float f32x4 __attribute__((ext_vector_type(4)));
typedef unsigned u32x4 __attribute__((ext_vector_type(4)));
constexpr int BM = 256, BK = 64, HALF = 128, HTB = HALF * BK * 2  , STAGE_BYTES = 8 * HTB, NXCD = 8, WGM = 8;

__host__ __device__ __forceinline__ int lds_byte(int r, int c) { const int st = (r >> 4) * 2 + (c >> 5), rr = r & 15, cc = c & 31, ob = rr * 64 + cc * 2; return st * 1024 + (ob ^ (((ob >> 9) & 1) << 5)); }
__host__ __device__ __forceinline__ void stage_rc(int b, int& R, int& C) { const int st = b / 1024, sb = b % 1024, swz = sb ^ (((sb >> 9) & 1) << 5); R = (st >> 1) * 16 + swz / 64; C = (st & 1) * 32 + (swz % 64) / 2; }
__host__ __device__ __forceinline__ int perm32(int rho) { const int n = rho >> 4, i = rho & 15; return 8 * (i >> 2) + 4 * n + (i & 3); }

struct Unit { int pm, pn; };
struct Gemm { const bf16_t* A; const bf16_t* Bt; int M, N, K; };

struct StaticOrder {
    int nM, nN, nwg, G, c;
    __host__ __device__ void init(int M, int N, int G_, int c_) { nM = M / BM; nN = N / BM; nwg = nM * nN; G = G_; c = c_; }
    __host__ __device__ bool next(int i, Unit& u) const {
        const long L = (long)i * G + c; if (L >= nwg) return false;
        int wgid = (int)L; { const int q = nwg / NXCD, r = nwg % NXCD, xcd = wgid % NXCD, off = wgid / NXCD; wgid = (xcd < r ? xcd * (q + 1) : r * (q + 1) + (xcd - r) * q) + off; }
        const int nig = WGM * nN, gid = wgid / nig, fm = gid * WGM, gsz = (nM - fm) < WGM ? (nM - fm) : WGM;
        u.pm = fm + ((wgid % nig) % gsz); u.pn = (wgid % nig) / gsz; return true;
    }
    __device__ __forceinline__ void a_ready(const Unit&) const {}
    __device__ __forceinline__ void done(const Unit&) const {}
};

__device__ __forceinline__ unsigned cvt_pk_bf16(float lo, float hi) { unsigned r; asm volatile("v_cvt_pk_bf16_f32 %0, %1, %2" : "=v"(r) : "v"(lo), "v"(hi)); return r; }
template <class Epi, class Sched, bool ALIGN_EPI = false, bool SP2 = false>
__device__ __forceinline__ void gemm_phase(PG8_LAS unsigned char* lds, const Gemm g, const Sched& S, const Epi& E) {
    int tid_raw = threadIdx.x; asm volatile("" : "+v"(tid_raw));
    const int tid = tid_raw, wid = __builtin_amdgcn_readfirstlane(tid >> 6), lane = tid & 63, wr = wid >> 2, wc = wid & 3, fr = lane & 15, fq = lane >> 4;
    const int K = g.K, nt = K / BK;
    unsigned voffA[2], voffB[2];
#pragma unroll
    for (int i = 0; i < 2; ++i) { int R, C; stage_rc(tid * 16 + i * 8192, R, C); const int Rb = Epi::PERM ? ((R & ~31) + perm32(R & 31)) : R;
        voffA[i] = (unsigned)(R * K + C) * 2u; voffB[i] = (unsigned)(Rb * K + C) * 2u; }
    const size_t kstep = (size_t)(BK * 2);
    const size_t hstep = (size_t)HALF * K * 2;
    const size_t tstep = 2 * hstep;
    const unsigned ldsw = (unsigned)wid * 1024u;
    const int aoff = lds_byte(wr * 64 + fr, fq * 8), boff = lds_byte(wc * 32 + fr, fq * 8);
#define PG8_SA(b, h) (((b) * 2 + (h)) * HTB)
#define PG8_SB(b, h) ((4 + (b) * 2 + (h)) * HTB)
#define PG8_STAGE(bufoff, gbase, voff) do { _Pragma("unroll") for (int _i = 0; _i < 2; ++_i) \
        __builtin_amdgcn_global_load_lds((const unsigned*)((const char*)(gbase) + (voff)[_i]), (PG8_LAS unsigned*)(lds + (bufoff) + ldsw + _i * 8192), 16, 0, 0); } while (0)
#define PG8_LDA(dst, b, h) do { _Pragma("unroll") for (int m = 0; m < 4; ++m) _Pragma("unroll") for (int k = 0; k < 2; ++k) dst[m][k] = *(const PG8_LAS bf16x8*)(lds + PG8_SA(b, h) + aoff + m * 2048 + k * 1024); } while (0)
#define PG8_LDB(dst, b, h) do { _Pragma("unroll") for (int n = 0; n < 2; ++n) _Pragma("unroll") for (int k = 0; k < 2; ++k) dst[n][k] = *(const PG8_LAS bf16x8*)(lds + PG8_SB(b, h) + boff + n * 2048 + k * 1024); } while (0)
#define PG8_MMA(ai, bj, At, Bt) do { __builtin_amdgcn_s_setprio(1); _Pragma("unroll") for (int m = 0; m < 4; ++m) _Pragma("unroll") for (int n = 0; n < 2; ++n) _Pragma("unroll") for (int k = 0; k < 2; ++k) \
        acc[ai][bj][m][n] = __builtin_amdgcn_mfma_f32_16x16x32_bf16(Bt[n][k], At[m][k], acc[ai][bj][m][n], 0, 0, 0); __builtin_amdgcn_s_setprio(0); } while (0)
#define PG8_WAIT_V(n) asm volatile("s_waitcnt vmcnt(" #n ")" ::: "memory")
#define PG8_WAIT_L(n) asm volatile("s_waitcnt lgkmcnt(" #n ")" ::: "memory")
#define PG8_BAR __builtin_amdgcn_s_barrier()
#define PG8_SCHED __builtin_amdgcn_sched_barrier(0)
    Unit cur, nxt; int ui = 0;
    if (!S.next(0, cur)) return;
    f32x4 acc[2][2][4][2];
#pragma unroll
    for (int a = 0; a < 2; ++a)
#pragma unroll
        for (int b = 0; b < 2; ++b)
#pragma unroll
            for (int m = 0; m < 4; ++m)
#pragma unroll
                for (int n = 0; n < 2; ++n) acc[a][b][m][n] = (f32x4){0.f, 0.f, 0.f, 0.f};
    bf16x8 At[4][2], B0[2][2], B1[2][2];
    const char* cA = (const char*)g.A + (size_t)cur.pm * tstep; const char* cB = (const char*)g.Bt + (size_t)cur.pn * tstep;
    S.a_ready(cur);
    if constexpr (SP2) {
        PG8_STAGE(PG8_SB(0, 0), cB, voffB); PG8_STAGE(PG8_SB(0, 1), cB + hstep, voffB); PG8_STAGE(PG8_SA(0, 0), cA, voffA); PG8_STAGE(PG8_SA(0, 1), cA + hstep, voffA);
        if (wr == 1) PG8_BAR;
        PG8_WAIT_V(2); PG8_BAR;
        PG8_STAGE(PG8_SB(1, 0), cB + kstep, voffB); PG8_STAGE(PG8_SA(1, 0), cA + kstep, voffA); PG8_STAGE(PG8_SB(1, 1), cB + hstep + kstep, voffB);
        PG8_WAIT_V(6); PG8_BAR;
    } else {
        PG8_STAGE(PG8_SB(0, 0), cB, voffB); PG8_STAGE(PG8_SA(0, 0), cA, voffA); PG8_STAGE(PG8_SB(0, 1), cB + hstep, voffB); PG8_STAGE(PG8_SA(0, 1), cA + hstep, voffA);
        if (wr == 1) PG8_BAR;
        PG8_WAIT_V(4); PG8_BAR;
        PG8_STAGE(PG8_SB(1, 0), cB + kstep, voffB); PG8_STAGE(PG8_SA(1, 0), cA + kstep, voffA); PG8_STAGE(PG8_SB(1, 1), cB + hstep + kstep, voffB);
        PG8_WAIT_V(6); PG8_BAR;
    }
    for (;;) {
        const bool has_next = S.next(ui + 1, nxt);
        const char* nA = has_next ? (const char*)g.A + (size_t)nxt.pm * tstep : cA; const char* nB = has_next ? (const char*)g.Bt + (size_t)nxt.pn * tstep : cB;
        for (int t = 0; t < nt; t += 2) {
            const bool last = (t == nt - 2);
            const char* a1 = cA + (size_t)(t + 1) * kstep;
            const char* a2 = last ? nA : cA + (size_t)(t + 2) * kstep; const char* b2 = last ? nB : cB + (size_t)(t + 2) * kstep;
            const char* a3 = a2 + kstep; const char* b3 = b2 + kstep;
            if (last && has_next) S.a_ready(nxt);
            if constexpr (SP2) {
            PG8_LDB(B0, 0, 0); PG8_LDB(B1, 0, 1); PG8_SCHED; PG8_LDA(At, 0, 0); PG8_STAGE(PG8_SA(1, 1), a1 + hstep, voffA);
            PG8_WAIT_V(8); PG8_WAIT_L(0); PG8_BAR; PG8_MMA(0, 0, At, B0); PG8_MMA(0, 1, At, B1); PG8_BAR; PG8_SCHED;
            PG8_LDA(At, 0, 1); PG8_STAGE(PG8_SB(0, 0), b2, voffB); PG8_STAGE(PG8_SB(0, 1), b2 + hstep, voffB); PG8_STAGE(PG8_SA(0, 0), a2, voffA);
            PG8_WAIT_V(8); PG8_WAIT_L(0); PG8_BAR; PG8_MMA(1, 0, At, B0); PG8_MMA(1, 1, At, B1); PG8_BAR; PG8_SCHED;
            PG8_LDB(B0, 1, 0); PG8_LDB(B1, 1, 1); PG8_SCHED; PG8_LDA(At, 1, 0); PG8_STAGE(PG8_SA(0, 1), a2 + hstep, voffA);
            PG8_WAIT_V(8); PG8_WAIT_L(0); PG8_BAR; PG8_MMA(0, 0, At, B0); PG8_MMA(0, 1, At, B1); PG8_BAR; PG8_SCHED;
            PG8_LDA(At, 1, 1); PG8_STAGE(PG8_SB(1, 0), b3, voffB); PG8_STAGE(PG8_SB(1, 1), b3 + hstep, voffB); PG8_STAGE(PG8_SA(1, 0), a3, voffA);
            PG8_WAIT_V(8); PG8_WAIT_L(0); PG8_BAR; PG8_MMA(1, 0, At, B0); PG8_MMA(1, 1, At, B1); PG8_BAR; PG8_SCHED;
            } else {
            PG8_LDB(B0, 0, 0); PG8_SCHED; PG8_LDA(At, 0, 0); PG8_STAGE(PG8_SA(1, 1), a1 + hstep, voffA);
            PG8_WAIT_L(8); PG8_BAR; PG8_WAIT_L(0); PG8_MMA(0, 0, At, B0); PG8_BAR; PG8_SCHED;
            PG8_LDB(B1, 0, 1); PG8_STAGE(PG8_SB(0, 0), b2, voffB);
            PG8_BAR; PG8_WAIT_L(0); PG8_MMA(0, 1, At, B1); PG8_BAR;
            PG8_LDA(At, 0, 1); PG8_STAGE(PG8_SA(0, 0), a2, voffA);
            PG8_BAR; PG8_WAIT_L(0); PG8_MMA(1, 0, At, B0); PG8_BAR; PG8_SCHED;
            PG8_STAGE(PG8_SB(0, 1), b2 + hstep, voffB);
            PG8_WAIT_V(6); PG8_BAR; PG8_MMA(1, 1, At, B1); PG8_BAR;
            PG8_LDB(B0, 1, 0); PG8_SCHED; PG8_LDA(At, 1, 0); PG8_STAGE(PG8_SA(0, 1), a2 + hstep, voffA);
            PG8_WAIT_L(8); PG8_BAR; PG8_WAIT_L(0); PG8_MMA(0, 0, At, B0); PG8_BAR; PG8_SCHED;
            PG8_LDB(B1, 1, 1); PG8_STAGE(PG8_SB(1, 0), b3, voffB);
            PG8_BAR; PG8_WAIT_L(0); PG8_MMA(0, 1, At, B1); PG8_BAR;
            PG8_LDA(At, 1, 1); PG8_STAGE(PG8_SA(1, 0), a3, voffA);
            PG8_BAR; PG8_WAIT_L(0); PG8_MMA(1, 0, At, B0); PG8_BAR; PG8_SCHED;
            PG8_STAGE(PG8_SB(1, 1), b3 + hstep, voffB);
            PG8_WAIT_V(6); PG8_BAR; PG8_MMA(1, 1, At, B1); PG8_BAR;
            }
        }
        if constexpr (ALIGN_EPI) { if (wr == 0) PG8_BAR; }
        if constexpr (!Epi::AFTER_DRAIN) { E(acc, cur, wr, wc, fr, fq); S.done(cur); }
        if (!has_next) break;
#pragma unroll
        for (int a = 0; a < 2; ++a)
#pragma unroll
            for (int b = 0; b < 2; ++b)
#pragma unroll
                for (int m = 0; m < 4; ++m)
#pragma unroll
                    for (int n = 0; n < 2; ++n) acc[a][b][m][n] = (f32x4){0.f, 0.f, 0.f, 0.f};
        cur = nxt; cA = nA; cB = nB; ++ui;
        if constexpr (ALIGN_EPI) { if (wr == 1) PG8_BAR; }
    }
    PG8_WAIT_V(0);
    if constexpr (!ALIGN_EPI) { if (wr == 0) PG8_BAR; }
    PG8_BAR;
    if constexpr (Epi::AFTER_DRAIN) { E.fused(acc, cur, wr, wc, fr, fq, lds, wid, lane); S.done(cur); }
#undef PG8_SA
#undef PG8_SB
#undef PG8_STAGE
#undef PG8_LDA
#undef PG8_LDB
#undef PG8_MMA
#undef PG8_WAIT_V
#undef PG8_WAIT_L
#undef PG8_BAR
#undef PG8_SCHED
}
}

#define LAS __attribute__((address_space(3)))
typedef unsigned short bf16;
typedef unsigned v4u __attribute__((ext_vector_type(4)));
typedef unsigned v2u __attribute__((ext_vector_type(2)));
typedef float v4f __attribute__((ext_vector_type(4)));
typedef float v16f __attribute__((ext_vector_type(16)));
typedef short v8s __attribute__((ext_vector_type(8)));

constexpr int NTOK = 16384, DM = 2048, SEQ = 4096, DFF = 5632, TOKW = 1536;
constexpr float EPS = 1e-6f;
constexpr float LOG2E = 1.4426950408889634f;
constexpr float QSCALE_MLA = 0.07216878364870322f * LOG2E, QSCALE_MEM = 0.08838834764831845f * LOG2E;

constexpr size_t MiB = 1u << 20;
constexpr size_t WS_CTL = 0;
constexpr size_t WS_COS = 1 * MiB, WS_SIN = 3 * MiB;
constexpr size_t WS_MEMN = 5 * MiB, WS_KMEM = 9 * MiB, WS_VMT = 11 * MiB, WS_WS = 13 * MiB;
constexpr size_t WS_WAIN = 14 * MiB, WS_WAOUT = 28 * MiB, WS_WGU0 = 36 * MiB, WS_WDN0 = 80 * MiB, WS_MIXB = 14 * MiB;
constexpr size_t WS_WMK = 102 * MiB, WS_WMV = 106 * MiB, WS_WGU1 = 110 * MiB, WS_WDN1 = 154 * MiB, WS_WBIN = 176 * MiB;
constexpr size_t WS_WUK = 183 * MiB, WS_WUV = 184 * MiB + 512 * 1024, WS_WUQ = 186 * MiB, WS_WBOUT = 189 * MiB;
constexpr size_t WS_HN = 197 * MiB;
constexpr size_t WS_ACT = 261 * MiB;
constexpr size_t WS_U = 261 * MiB, WS_VA = 309 * MiB, WS_MQ = 357 * MiB, WS_MIXA = 373 * MiB;
constexpr size_t WS_GOUT = 437 * MiB;
constexpr size_t WS_CKV = 261 * MiB, WS_ZQ = 277 * MiB, WS_KR = 293 * MiB, WS_MQB = 295 * MiB, WS_KN = 311 * MiB, WS_VT = 359 * MiB, WS_Q = 407 * MiB;
constexpr size_t WS_ST = 501 * MiB;
constexpr size_t WS_END = 504 * MiB;
constexpr int ST_VSUM = 0, ST_VSS = 16384 * 24;
constexpr int ST_G = 0;
constexpr int ST_CKV = 0, ST_CKVC = 16384 * 8, ST_Q = 2 * 16384 * 8;
constexpr int CTL_QUEUE = 0;
constexpr int CW_BAR = 1024;
constexpr size_t CTL_ZERO_BYTES = 65536;
constexpr size_t WS_HSS = 256 * 1024;

constexpr int LDS_BYTES = 147456;
constexpr int LDS_MISC = 131072;

struct Args { const float* in[24]; float* out; unsigned char* ws; int ph_lo, ph_hi; };

__device__ __forceinline__ float wave_sum(float v) {
#pragma unroll
    for (int o = 1; o < 64; o <<= 1) v += __shfl_xor(v, o);
    return v;
}
__device__ __forceinline__ unsigned pk2(float lo, float hi) { return pg8::cvt_pk_bf16(lo, hi); }
typedef float v2f_ __attribute__((ext_vector_type(2)));
typedef __bf16 v2bf_ __attribute__((ext_vector_type(2)));
__device__ __forceinline__ unsigned pk2b(float lo, float hi) { return __builtin_bit_cast(unsigned, __builtin_convertvector((v2f_){lo, hi}, v2bf_)); }
__device__ __forceinline__ float bf_lo(unsigned u) { return __uint_as_float(u << 16); }
__device__ __forceinline__ float bf_hi(unsigned u) { return __uint_as_float(u & 0xffff0000u); }
__device__ __forceinline__ void store8(bf16* p, v4f a, v4f b) { v4u w; w.x = pk2(a[0], a[1]); w.y = pk2(a[2], a[3]); w.z = pk2(b[0], b[1]); w.w = pk2(b[2], b[3]); *(v4u*)p = w; }
__device__ __forceinline__ float gelu_tanh(float x) {
    constexpr float K1 = -2.0f * LOG2E * 0.7978845608028654f, K2 = K1 * 0.044715f;
    const float y = x * __builtin_fmaf(K2, x * x, K1);
    return x * __builtin_amdgcn_rcpf(1.0f + __builtin_amdgcn_exp2f(y));
}
__device__ __forceinline__ float silu_mul(float g, float u) { return g * u * __builtin_amdgcn_rcpf(1.0f + __builtin_amdgcn_exp2f(-LOG2E * g)); }
__device__ __forceinline__ v4f gelu4(v4f v) { return (v4f){gelu_tanh(v[0]), gelu_tanh(v[1]), gelu_tanh(v[2]), gelu_tanh(v[3])}; }
__device__ __forceinline__ float sum4(v4f v) { return (v[0] + v[1]) + (v[2] + v[3]); }
__device__ __forceinline__ float ssq4(v4f v) { return (v[0] * v[0] + v[1] * v[1]) + (v[2] * v[2] + v[3] * v[3]); }

enum { EK_STORE = 0, EK_AIN = 1, EK_GATEUP = 2, EK_BIN = 3, EK_UQ = 4, EK_P9 = 5 };
constexpr int VT_CKV = (int)(WS_CKV >> 18), VT_WUK = (int)(WS_WUK >> 18), VT_WUV = (int)(WS_WUV >> 18), VT_ZQ = (int)(WS_ZQ >> 18), VT_WUQ = (int)(WS_WUQ >> 18);
static_assert((WS_CKV & 262143) == 0 && (WS_WUK & 262143) == 0 && (WS_WUV & 262143) == 0 && (WS_ZQ & 262143) == 0 && (WS_WUQ & 262143) == 0, "phase-9 operands sit on 256-KiB tile boundaries");
struct Epi {
    static constexpr bool PERM = true, AFTER_DRAIN = false;
    int kind, scale_mode  , accss, ldc;
    bf16* o0; const float* ssin; float inv_n; float* ss0; int nslots; int vt_nt; unsigned char* wsb;
    int pm_cached; LAS const float* lrs;
    __device__ __forceinline__ void operator()(const pg8::f32x4 (&acc)[2][2][4][2], const pg8::Unit& u, int wr_, int wc_, int fr_, int fq_) const {
        int tid_ = threadIdx.x; asm volatile("" : "+v"(tid_));
        const int wr = tid_ >> 8, wc = (tid_ >> 6) & 3, fr = tid_ & 15, fq = (tid_ >> 4) & 3;
        int kind_ = kind, scale_ = scale_mode, ldc_ = ldc, pm_ = __builtin_amdgcn_readfirstlane(u.pm), pn = __builtin_amdgcn_readfirstlane(u.pn);
        bf16* o0_ = o0; const float* ssin_ = ssin;
        if (kind == EK_P9) {
            if (pn >= VT_WUK && pn < VT_WUK + 6) { kind_ = EK_STORE; scale_ = 1; ldc_ = 1536; pn -= VT_WUK; pm_ -= VT_CKV; o0_ = (bf16*)(wsb + WS_KN); ssin_ = (const float*)(wsb + WS_ST) + ST_CKV; }
            else if (pn >= VT_WUQ && pn < VT_WUQ + 9) { kind_ = EK_UQ; pn -= VT_WUQ; pm_ -= VT_ZQ; o0_ = (bf16*)(wsb + WS_Q); ssin_ = (const float*)(wsb + WS_ST) + ST_Q; }
            else { kind_ = EK_STORE; scale_ = 2; ldc_ = NTOK; pn -= VT_CKV; pm_ -= VT_WUV; o0_ = (bf16*)(wsb + WS_VT); ssin_ = (const float*)(wsb + WS_ST) + ST_CKVC; }
        }
        const int row0 = pm_ * 256 + wr * 64 + fr;
        const int cl = wc * 32 + 8 * fq;
        if (kind_ == EK_STORE) {
            const int col0 = pn * 256 + cl;
            if (scale_ == 2) {
                v4f cs[2][2];
#pragma unroll
                for (int bj = 0; bj < 2; ++bj)
#pragma unroll
                    for (int n = 0; n < 2; ++n) { v4f t = *(const v4f*)(ssin_ + col0 + bj * 128 + 4 * n);
#pragma unroll
                        for (int sl = 1; sl < 8; ++sl) t += *(const v4f*)(ssin_ + sl * 16384 + col0 + bj * 128 + 4 * n);
                        cs[bj][n] = (v4f){__builtin_amdgcn_rsqf(t[0] * inv_n + EPS), __builtin_amdgcn_rsqf(t[1] * inv_n + EPS), __builtin_amdgcn_rsqf(t[2] * inv_n + EPS), __builtin_amdgcn_rsqf(t[3] * inv_n + EPS)}; }
#pragma unroll
                for (int ai = 0; ai < 2; ++ai)
#pragma unroll
                    for (int m = 0; m < 4; ++m) {
                        const int row = row0 + ai * 128 + m * 16;
#pragma unroll
                        for (int bj = 0; bj < 2; ++bj) { const int tk = col0 + bj * 128;
                            store8(o0_ + (unsigned)((((row >> 7) * 256 + (tk >> 6)) * 128 + (row & 127)) * 64 + (tk & 63)), acc[ai][bj][m][0] * cs[bj][0], acc[ai][bj][m][1] * cs[bj][1]); }
                    }
            } else {
                float rsv8[8];
#pragma unroll
                for (int i = 0; i < 8; ++i) { rsv8[i] = 1.f; if (scale_ == 1) { const int row = row0 + (i >> 2) * 128 + (i & 3) * 16; const v4f t0 = *(const v4f*)(ssin_ + (unsigned)(row * 8)), t1 = *(const v4f*)(ssin_ + (unsigned)(row * 8) + 4); rsv8[i] = __builtin_amdgcn_rsqf((sum4(t0) + sum4(t1)) * inv_n + EPS); } }
#pragma unroll
                for (int ai = 0; ai < 2; ++ai)
#pragma unroll
                    for (int m = 0; m < 4; ++m) {
                        const int row = row0 + ai * 128 + m * 16;
                        const float rs = rsv8[ai * 4 + m];
                        float q = 0.f;
#pragma unroll
                        for (int bj = 0; bj < 2; ++bj) {
                            const v4f v0 = acc[ai][bj][m][0] * rs, v1 = acc[ai][bj][m][1] * rs;
                            q += ssq4(v0) + ssq4(v1);
                            const int tk = col0 + bj * 128;
                            const unsigned off = vt_nt ? (unsigned)((((row >> 7) * vt_nt + (tk >> 6)) * 128 + (row & 127)) * 64 + (tk & 63)) : (unsigned)(row * ldc_ + tk);
                            store8(o0_ + off, v0, v1);
                        }
                        if (accss) { q += __shfl_xor(q, 16); q += __shfl_xor(q, 32); if (fq == 0) ss0[(unsigned)(row * nslots + pn * 4 + wc)] = q; }
                    }
            }
        } else if (kind_ == EK_AIN) {
            const int k3 = pn < 6 ? 0 : (pn < 12 ? 1 : 2);
            bf16* base = (bf16*)(wsb + (k3 == 0 ? WS_U : (k3 == 1 ? WS_VA : WS_MQ)));
            const int ld = k3 == 2 ? 512 : 1536;
            float* const ss0 = (float*)(wsb + WS_ST) + ST_VSUM; float* const ss1 = (float*)(wsb + WS_ST) + ST_VSS;
            const int col0 = (k3 == 0 ? pn : (k3 == 1 ? pn - 6 : pn - 12)) * 256 + cl;
#pragma unroll
            for (int ai = 0; ai < 2; ++ai)
#pragma unroll
                for (int m = 0; m < 4; ++m) {
                    const int row = row0 + ai * 128 + m * 16;
                    float s1 = 0.f, s2 = 0.f;
#pragma unroll
                    for (int bj = 0; bj < 2; ++bj) {
                        v4f v0 = acc[ai][bj][m][0], v1 = acc[ai][bj][m][1];
                        if (k3 < 2) { v0 = gelu4(v0); v1 = gelu4(v1); } else { v0 = v0 * QSCALE_MEM; v1 = v1 * QSCALE_MEM; }
                        s1 += sum4(v0) + sum4(v1); s2 += ssq4(v0) + ssq4(v1);
                        store8(base + (unsigned)(row * ld + col0) + bj * 128, v0, v1);
                    }
                    if (k3 == 1) { s1 += __shfl_xor(s1, 16); s1 += __shfl_xor(s1, 32); s2 += __shfl_xor(s2, 16); s2 += __shfl_xor(s2, 32);
                        if (fq == 0) { const unsigned si = (unsigned)(row * 24 + (pn - 6) * 4 + wc); ss0[si] = s1; ss1[si] = s2; } }
                }
        } else if (kind_ == EK_GATEUP) {
            const int col0 = pn * 128 + cl;
            float rsv[8];
            if (__builtin_amdgcn_readfirstlane(u.pm) == pm_cached) {
                const v4f r0 = *(LAS const v4f*)(lrs + (wr * 16 + fr) * 8), r1 = *(LAS const v4f*)(lrs + (wr * 16 + fr) * 8 + 4);
#pragma unroll
                for (int i = 0; i < 4; ++i) { rsv[i] = r0[i]; rsv[4 + i] = r1[i]; }
            } else { const float* hp = (const float*)(wsb + WS_HSS) + u.pm * 256 + (wr * 16 + fr) * 8; const v4f r0 = *(const v4f*)hp, r1 = *(const v4f*)(hp + 4);
#pragma unroll
              for (int i = 0; i < 4; ++i) { rsv[i] = __builtin_amdgcn_rsqf(r0[i] * (1.f / DM) + EPS); rsv[4 + i] = __builtin_amdgcn_rsqf(r1[i] * (1.f / DM) + EPS); } }
#pragma unroll
            for (int ai = 0; ai < 2; ++ai)
#pragma unroll
                for (int m = 0; m < 4; ++m) {
                    const int row = row0 + ai * 128 + m * 16;
                    const float rs = rsv[ai * 4 + m];
                    const float c1 = -LOG2E * rs, rs2 = rs * rs;
                    v4f a0, a1;
#pragma unroll
                    for (int e = 0; e < 4; ++e) {
                        const float g0_ = acc[ai][0][m][0][e], g1_ = acc[ai][0][m][1][e];
                        a0[e] = (g0_ * acc[ai][1][m][0][e]) * (rs2 * __builtin_amdgcn_rcpf(1.0f + __builtin_amdgcn_exp2f(g0_ * c1)));
                        a1[e] = (g1_ * acc[ai][1][m][1][e]) * (rs2 * __builtin_amdgcn_rcpf(1.0f + __builtin_amdgcn_exp2f(g1_ * c1))); }
                    store8(o0 + (unsigned)(row * DFF + col0), a0, a1);
                }
        } else if (kind_ == EK_BIN) {
            const float* const cosT = (const float*)(wsb + WS_COS); const float* const sinT = (const float*)(wsb + WS_SIN); bf16* const o2 = (bf16*)(wsb + WS_KR);
            float rsv[8];
            if (__builtin_amdgcn_readfirstlane(u.pm) == pm_cached) {
                const v4f r0 = *(LAS const v4f*)(lrs + (wr * 16 + fr) * 8), r1 = *(LAS const v4f*)(lrs + (wr * 16 + fr) * 8 + 4);
#pragma unroll
                for (int i = 0; i < 4; ++i) { rsv[i] = r0[i]; rsv[4 + i] = r1[i]; }
            } else { const float* hp = (const float*)(wsb + WS_HSS) + u.pm * 256 + (wr * 16 + fr) * 8; const v4f r0 = *(const v4f*)hp, r1 = *(const v4f*)(hp + 4);
#pragma unroll
              for (int i = 0; i < 4; ++i) { rsv[i] = __builtin_amdgcn_rsqf(r0[i] * (1.f / DM) + EPS); rsv[4 + i] = __builtin_amdgcn_rsqf(r1[i] * (1.f / DM) + EPS); } }
            if (pn == 2) {
                if (wc == 0) {
#pragma unroll
                    for (int ai = 0; ai < 2; ++ai)
#pragma unroll
                        for (int m = 0; m < 4; ++m) {
                            const int row = row0 + ai * 128 + m * 16;
                            const float rs = rsv[ai * 4 + m];
                            v4f y1[2], y2[2];
#pragma unroll
                            for (int n = 0; n < 2; ++n) { const v4f c = *(const v4f*)(cosT + (unsigned)(row * 32) + 8 * fq + 4 * n), s = *(const v4f*)(sinT + (unsigned)(row * 32) + 8 * fq + 4 * n);
                                const v4f x1 = acc[ai][0][m][n] * rs, x2 = acc[ai][1][m][n] * rs; y1[n] = x1 * c - x2 * s; y2[n] = x2 * c + x1 * s; }
                            store8(o2 + (unsigned)(row * 64) + 8 * fq, y1[0], y1[1]);
                            store8(o2 + (unsigned)(row * 64) + 32 + 8 * fq, y2[0], y2[1]);
                        }
                }
            } else {
                const int k3 = pn < 2 ? 0 : (pn < 5 ? 1 : 2);
                bf16* base = (bf16*)(wsb + (k3 == 0 ? WS_CKV : (k3 == 1 ? WS_ZQ : WS_MQB)));
                float* ssp = (float*)(wsb + WS_ST) + (k3 == 0 ? ST_CKV : ST_Q); float* const ssc = (float*)(wsb + WS_ST) + ST_CKVC;
                const int col0 = (k3 == 0 ? pn : (k3 == 1 ? pn - 3 : pn - 5)) * 256 + cl;
#pragma unroll
                for (int ai = 0; ai < 2; ++ai)
#pragma unroll
                    for (int m = 0; m < 4; ++m) {
                        const int row = row0 + ai * 128 + m * 16;
                        const float rs = rsv[ai * 4 + m] * (k3 == 2 ? QSCALE_MEM : 1.f);
                        float q = 0.f;
#pragma unroll
                        for (int bj = 0; bj < 2; ++bj) {
                            const v4f v0 = acc[ai][bj][m][0] * rs, v1 = acc[ai][bj][m][1] * rs;
                            q += ssq4(v0) + ssq4(v1);
                            store8(base + (unsigned)(row * 512 + col0) + bj * 128, v0, v1);
                        }
                        if (k3 < 2) { q += __shfl_xor(q, 16); q += __shfl_xor(q, 32); const int sl = (k3 == 0 ? pn : pn - 3) * 4 + wc;
                            if (fq == 0) { ssp[(unsigned)(row * 8 + sl)] = q; if (k3 == 0) ssc[(unsigned)(sl * 16384 + row)] = q; } }
                    }
            }
        } else {
            const float* const cosT = (const float*)(wsb + WS_COS); const float* const sinT = (const float*)(wsb + WS_SIN);
            float rsv8[8];
#pragma unroll
            for (int i = 0; i < 8; ++i) { const int row = row0 + (i >> 2) * 128 + (i & 3) * 16; const v4f t0 = *(const v4f*)(ssin_ + (unsigned)(row * 8)), t1 = *(const v4f*)(ssin_ + (unsigned)(row * 8) + 4);
                rsv8[i] = __builtin_amdgcn_rsqf((sum4(t0) + sum4(t1)) * inv_n + EPS) * QSCALE_MLA; }
            if (pn < 6) {
#pragma unroll
                for (int ai = 0; ai < 2; ++ai)
#pragma unroll
                    for (int m = 0; m < 4; ++m) {
                        const int row = row0 + ai * 128 + m * 16; const float rs = rsv8[ai * 4 + m];
                        bf16* qrow = o0_ + (unsigned)(row * 2304);
#pragma unroll
                        for (int bj = 0; bj < 2; ++bj) store8(qrow + (pn * 2 + bj) * 192 + cl, acc[ai][bj][m][0] * rs, acc[ai][bj][m][1] * rs);
                    }
            } else {
                const int head = 4 * (pn - 6) + wc;
#pragma unroll
                for (int h2 = 0; h2 < 4; ++h2) {
                    const int ai = h2 >> 1, mb = (h2 & 1) * 2;
                    v4f cc[2][2], sn[2][2];
#pragma unroll
                    for (int mm = 0; mm < 2; ++mm)
#pragma unroll
                        for (int n = 0; n < 2; ++n) { const int row = row0 + ai * 128 + (mb + mm) * 16; cc[mm][n] = *(const v4f*)(cosT + (unsigned)(row * 32) + 8 * fq + 4 * n); sn[mm][n] = *(const v4f*)(sinT + (unsigned)(row * 32) + 8 * fq + 4 * n); }
#pragma unroll
                    for (int mm = 0; mm < 2; ++mm) {
                        const int m = mb + mm;
                        const int row = row0 + ai * 128 + m * 16; const float rs = rsv8[ai * 4 + m];
                        bf16* qrow = o0_ + (unsigned)(row * 2304);
                        v4f y1[2], y2[2];
#pragma unroll
                        for (int n = 0; n < 2; ++n) { const v4f x1 = acc[ai][0][m][n] * rs, x2 = acc[ai][1][m][n] * rs; y1[n] = x1 * cc[mm][n] - x2 * sn[mm][n]; y2[n] = x2 * cc[mm][n] + x1 * sn[mm][n]; }
                        store8(qrow + head * 192 + 128 + 8 * fq, y1[0], y1[1]);
                        store8(qrow + head * 192 + 160 + 8 * fq, y2[0], y2[1]);
                    }
                }
            }
        }
    }
};

__device__ __forceinline__ void tr_load(float (&v)[32], const float* W, int ldw, int k0, int n0, int lane) {
    const float* src = W + (size_t)(k0 + (lane >> 5)) * ldw + n0 + (lane & 31);
#pragma unroll
    for (int i = 0; i < 32; ++i) v[i] = src[(size_t)(2 * i) * ldw];
}
__device__ __forceinline__ void tr_store(const float (&v)[32], int k0, const float* gain, bf16* dst, int K, LAS float* scr, int lane) {
    const int c = lane & 7;
    v4f g0 = (v4f){1.f, 1.f, 1.f, 1.f}, g1 = g0;
    if (gain) { g0 = *(const v4f*)(gain + k0 + 8 * c); g1 = *(const v4f*)(gain + k0 + 8 * c + 4); }
#pragma unroll
    for (int i = 0; i < 32; ++i) scr[(2 * i + (lane >> 5)) * 33 + (lane & 31)] = v[i];
    asm volatile("s_waitcnt lgkmcnt(0)" ::: "memory");
#pragma unroll
    for (int j = 0; j < 4; ++j) { const int n = (lane >> 3) + 8 * j; const LAS float* s = scr + (8 * c) * 33 + n;
        v4u o; o.x = pk2(s[0 * 33] * g0[0], s[1 * 33] * g0[1]); o.y = pk2(s[2 * 33] * g0[2], s[3 * 33] * g0[3]); o.z = pk2(s[4 * 33] * g1[0], s[5 * 33] * g1[1]); o.w = pk2(s[6 * 33] * g1[2], s[7 * 33] * g1[3]);
        *(v4u*)(dst + (size_t)n * K + k0 + 8 * c) = o; }
    asm volatile("s_waitcnt lgkmcnt(0)" ::: "memory");
}
constexpr int I_AIN = 32 * 112, I_MKV = 32 * 32, I_SQ = 32 * 64, I_GU = 32 * 176, I_DN = 88 * 64, I_KVA = 32 * 18, I_BIN = 32 * 32, I_UK = 8 * 48, I_UQ = 8 * 72;
constexpr int NITEMS = I_AIN + 2 * I_MKV + I_SQ + 4 * I_GU + 2 * I_DN + I_KVA + I_BIN + 2 * I_UK + I_UQ + I_SQ;
__device__ __forceinline__ void tr_decode(const Args& a, int it, const float*& W, int& ldw, int& k0, int& n0, const float*& gain, bf16*& dst, int& K) {
    unsigned char* ws = a.ws; const float* ng = a.in[3]; int r = it;
    if (r < I_AIN) { const int kb = r / 112, nb = r % 112; W = a.in[9]; ldw = 3584; k0 = 64 * kb; n0 = 32 * nb; gain = ng; dst = (bf16*)(ws + WS_WAIN) + (size_t)(32 * nb) * 2048; K = 2048; return; } r -= I_AIN;
    if (r < 2 * I_MKV) { const int l = r / I_MKV; r %= I_MKV; const int kb = r / 32, nb = r % 32; n0 = 32 * nb;
        dst = n0 < 512 ? (bf16*)(ws + WS_WMK) + (size_t)(l * 512 + n0) * 2048 : (bf16*)(ws + WS_WMV) + (size_t)(l * 512 + n0 - 512) * 2048;
        W = a.in[5] + (size_t)l * 2048 * 1024; ldw = 1024; k0 = 64 * kb; gain = a.in[4] + l * 2048; K = 2048; return; } r -= 2 * I_MKV;
    if (r < I_SQ) { const int kb = r / 64, nb = r % 64; W = a.in[14]; ldw = 2048; k0 = 64 * kb; n0 = 32 * nb; gain = nullptr; dst = (bf16*)(ws + WS_WAOUT) + (size_t)(32 * nb) * 2048; K = 2048; return; } r -= I_SQ;
    if (r < 4 * I_GU) { const int q = r / I_GU; r %= I_GU; const int l = q >> 1, isup = q & 1; const int kb = r / 176, nb = r % 176; n0 = 32 * nb;
        W = (isup ? a.in[7] : a.in[6]) + (size_t)l * 2048 * DFF; ldw = DFF; k0 = 64 * kb; gain = ng + (l * 4 + 2) * 2048; K = 2048;
        dst = (bf16*)(ws + (l ? WS_WGU1 : WS_WGU0)) + (size_t)(256 * (n0 / 128) + 128 * isup + (n0 % 128)) * 2048; return; } r -= 4 * I_GU;
    if (r < 2 * I_DN) { const int l = r / I_DN; r %= I_DN; const int kb = r / 64, nb = r % 64;
        W = a.in[8] + (size_t)l * DFF * 2048; ldw = 2048; k0 = 64 * kb; n0 = 32 * nb; gain = nullptr; dst = (bf16*)(ws + (l ? WS_WDN1 : WS_WDN0)) + (size_t)(32 * nb) * DFF; K = DFF; return; } r -= 2 * I_DN;
    if (r < I_KVA) { const int kb = r / 18, nb = r % 18; n0 = 32 * nb; const int drow = n0 < 512 ? n0 : (n0 == 512 ? 512 : 640);
        W = a.in[16]; ldw = 576; k0 = 64 * kb; gain = a.in[15]; dst = (bf16*)(ws + WS_WBIN) + (size_t)drow * 2048; K = 2048; return; } r -= I_KVA;
    if (r < I_BIN) { const int kb = r / 32, nb = r % 32; W = a.in[20]; ldw = 1024; k0 = 64 * kb; n0 = 32 * nb; gain = ng + 4 * 2048; dst = (bf16*)(ws + WS_WBIN) + (size_t)(768 + 32 * nb) * 2048; K = 2048; return; } r -= I_BIN;
    if (r < 2 * I_UK) { const int isv = r / I_UK; r %= I_UK; const int kb = r / 48, nb = r % 48;
        W = isv ? a.in[19] : a.in[18]; ldw = 1536; k0 = 64 * kb; n0 = 32 * nb; gain = a.in[17]; dst = (bf16*)(ws + (isv ? WS_WUV : WS_WUK)) + (size_t)(32 * nb) * 512; K = 512; return; } r -= 2 * I_UK;
    if (r < I_UQ) { const int kb = r / 72, nb = r % 72; n0 = 32 * nb; const int h = n0 / 192, d0 = n0 % 192;
        const int drow = d0 < 128 ? h * 128 + d0 : 1536 + 256 * (h >> 2) + 128 * ((d0 - 128) >> 5) + 32 * (h & 3);
        W = a.in[22]; ldw = 2304; k0 = 64 * kb; gain = a.in[21]; dst = (bf16*)(ws + WS_WUQ) + (size_t)drow * 512; K = 512; return; } r -= I_UQ;
    { const int kb = r / 64, nb = r % 64; W = a.in[23]; ldw = 2048; k0 = 64 * kb; n0 = 32 * nb; gain = nullptr; dst = (bf16*)(ws + WS_WBOUT) + (size_t)(32 * nb) * 2048; K = 2048; }
}
__device__ __forceinline__ void rms_row_bf16(const float* xrow, bf16* orow, int lane) {
    v4f v[8]; float s = 0.f;
#pragma unroll
    for (int j = 0; j < 4; ++j) { v[2 * j] = *(const v4f*)(xrow + 8 * (lane + 64 * j)); v[2 * j + 1] = *(const v4f*)(xrow + 8 * (lane + 64 * j) + 4); s += ssq4(v[2 * j]) + ssq4(v[2 * j + 1]); }
    const float rstd = __builtin_amdgcn_rsqf(wave_sum(s) * (1.f / DM) + EPS);
#pragma unroll
    for (int j = 0; j < 4; ++j) store8(orow + 8 * (lane + 64 * j), v[2 * j] * rstd, v[2 * j + 1] * rstd);
}

__device__ __forceinline__ void prologue(const Args& a, LAS unsigned char* lds) {
    int tid = threadIdx.x; asm volatile("" : "+v"(tid));
    const int lane = tid & 63, wave = __builtin_amdgcn_readfirstlane(tid >> 6);
    int G = gridDim.x; asm volatile("" : "+s"(G));
    const int gw = blockIdx.x * 8 + wave, NGW = G * 8, gt = blockIdx.x * 512 + tid, NGT = G * 512;
    unsigned char* ws = a.ws;
    for (int i = gt; i < 2 * 96 * 1024; i += NGT) { const int blk = i / (96 * 1024), r = i % (96 * 1024); ((unsigned*)(ws + WS_WBIN))[(size_t)(blk == 0 ? 544 : 672) * 1024 + r] = 0u; }
    { const float* wsrc = a.in[12]; bf16* wd = (bf16*)(ws + WS_WS);
      for (int i = gt; i < 12 * 128 * 128; i += NGT) { const int t = (i >> 7) & 127, s = i & 127; wd[i] = (bf16)(pk2(s <= t ? wsrc[i] : 0.f, 0.f) & 0xffffu); } }
    { const int* pos = (const int*)a.in[2]; float* ct = (float*)(ws + WS_COS); float* st = (float*)(ws + WS_SIN);
      for (int i = gt; i < NTOK * 32; i += NGT) { const int tok = i >> 5, k = i & 31;
          const double invf = (double)__builtin_amdgcn_exp2f(-(float)(2 * k) * (13.287712379549449f / 64.f));
          const double rev = (double)pos[tok] * invf * 0.15915494309189535; const float fr = (float)(rev - __builtin_floor(rev));
          ct[i] = __builtin_amdgcn_cosf(fr); st[i] = __builtin_amdgcn_sinf(fr); } }
    LAS float* scr = (LAS float*)(lds + wave * 16384);
    {
        float va[32], vb[32];
        const float *Wa, *Wb, *ga, *gb; int lda, ldb_, k0a, k0b, n0a, n0b, Ka, Kb2; bf16 *da, *db;
        int it = gw;
        if (it < NITEMS) { tr_decode(a, it, Wa, lda, k0a, n0a, ga, da, Ka); tr_load(va, Wa, lda, k0a, n0a, lane); }
        for (; it < NITEMS; it += 2 * NGW) {
            const int i2 = it + NGW; const bool h2 = i2 < NITEMS;
            if (h2) { tr_decode(a, i2, Wb, ldb_, k0b, n0b, gb, db, Kb2); tr_load(vb, Wb, ldb_, k0b, n0b, lane); }
            tr_store(va, k0a, ga, da, Ka, scr, lane);
            const int i3 = i2 + NGW;
            if (i3 < NITEMS) { tr_decode(a, i3, Wa, lda, k0a, n0a, ga, da, Ka); tr_load(va, Wa, lda, k0a, n0a, lane); }
            if (h2) tr_store(vb, k0b, gb, db, Kb2, scr, lane);
        }
    }
    for (int m = gw; m < NTOK; m += NGW) rms_row_bf16(a.in[0] + (size_t)m * DM, (bf16*)(ws + WS_HN) + (size_t)m * DM, lane);
    for (int m = gw; m < 1024; m += NGW) rms_row_bf16(a.in[1] + (size_t)m * DM, (bf16*)(ws + WS_MEMN) + (size_t)m * DM, lane);
}

__device__ __forceinline__ void rowpass(const float* hin32, bf16* hbf, const bf16* gout, const float* ss, const float* gain, float* hss, float* out32) {
    int tid_ = threadIdx.x; asm volatile("" : "+v"(tid_));
    const int lane = tid_ & 63, wave = __builtin_amdgcn_readfirstlane(tid_ >> 6), gw = blockIdx.x * 8 + wave, NGW = gridDim.x * 8;
    for (int m0 = gw; m0 < NTOK; m0 += 2 * NGW) {
        const int m1 = (m0 + NGW < NTOK) ? m0 + NGW : m0;
        float sp[2]; v4u g[2][4]; v4u hb16[2][4]; v4f hf[2][8];
#pragma unroll
        for (int r = 0; r < 2; ++r) { const int m = r ? m1 : m0;
            sp[r] = lane < 32 ? ss[(size_t)m * 32 + lane] : 0.f;
#pragma unroll
            for (int j = 0; j < 4; ++j) { const int c = 8 * (lane + 64 * j);
                g[r][j] = *(const v4u*)(gout + (size_t)m * DM + c);
                if (hin32) { hf[r][2 * j] = *(const v4f*)(hin32 + (size_t)m * DM + c); hf[r][2 * j + 1] = *(const v4f*)(hin32 + (size_t)m * DM + c + 4); }
                else hb16[r][j] = *(const v4u*)(hbf + (size_t)m * DM + c); } }
#pragma unroll
        for (int r = 0; r < 2; ++r) { const int m = r ? m1 : m0;
            const float rs = __builtin_amdgcn_rsqf(wave_sum(sp[r]) * (1.f / DM) + EPS);
            float s = 0.f;
#pragma unroll
            for (int j = 0; j < 4; ++j) { const int c = 8 * (lane + 64 * j);
                v4f h0, h1;
                if (hin32) { h0 = hf[r][2 * j]; h1 = hf[r][2 * j + 1]; }
                else { const v4u hv = hb16[r][j]; h0 = (v4f){bf_lo(hv.x), bf_hi(hv.x), bf_lo(hv.y), bf_hi(hv.y)}; h1 = (v4f){bf_lo(hv.z), bf_hi(hv.z), bf_lo(hv.w), bf_hi(hv.w)}; }
                const v4f g0 = *(const v4f*)(gain + c), g1 = *(const v4f*)(gain + c + 4);
                const v4u gg = g[r][j];
                const v4f a0 = (v4f){bf_lo(gg.x), bf_hi(gg.x), bf_lo(gg.y), bf_hi(gg.y)}, a1 = (v4f){bf_lo(gg.z), bf_hi(gg.z), bf_lo(gg.w), bf_hi(gg.w)};
                const v4f v0 = h0 + a0 * rs * g0, v1 = h1 + a1 * rs * g1;
                if (out32) { *(v4f*)(out32 + (size_t)m * DM + c) = v0; *(v4f*)(out32 + (size_t)m * DM + c + 4) = v1; }
                else { store8(hbf + (size_t)m * DM + c, v0, v1); s += ssq4(v0) + ssq4(v1); } }
            if (!out32) { const float t = wave_sum(s); const int rr = m & 255; if (lane == 0) hss[(m & ~255) + (((rr >> 6) & 1) * 16 + (rr & 15)) * 8 + (rr >> 7) * 4 + ((rr >> 4) & 3)] = t; } }
    }
}

__device__ __forceinline__ void gating_phase(const Args& a, LAS unsigned char* lds) {
    int tid = threadIdx.x; asm volatile("" : "+v"(tid));
    const int lane = tid & 63, w = __builtin_amdgcn_readfirstlane(tid >> 6);
    unsigned char* ws = a.ws;
    const bf16* U = (const bf16*)(ws + WS_U); const bf16* VA = (const bf16*)(ws + WS_VA); bf16* MIX = (bf16*)(ws + WS_MIXA);
    const bf16* WS_ = (const bf16*)(ws + WS_WS);
    const float* vsum = (const float*)(ws + WS_ST) + ST_VSUM; const float* vss = (const float*)(ws + WS_ST) + ST_VSS;
    LAS float* lst = (LAS float*)(lds + 36864);
    const float* lng = a.in[10]; const float* lnb = a.in[11]; const float* bs = a.in[13];
    constexpr int VP = 136;
    LAS bf16* vT = (LAS bf16*)lds;
    for (int unit = blockIdx.x; unit < 128 * 12; unit += gridDim.x) {
        const int n = unit / 12, g = unit % 12, T0 = 128 * n;
        if (tid < 128) { const float* p1 = vsum + (size_t)(T0 + tid) * 24; const float* p2 = vss + (size_t)(T0 + tid) * 24; float a1 = 0.f, a2 = 0.f;
#pragma unroll
            for (int k = 0; k < 6; ++k) { a1 += sum4(*(const v4f*)(p1 + 4 * k)); a2 += sum4(*(const v4f*)(p2 + 4 * k)); }
            const float mean = a1 * (1.f / TOKW), var = a2 * (1.f / TOKW) - mean * mean; lst[2 * tid] = mean; lst[2 * tid + 1] = __builtin_amdgcn_rsqf(var + EPS); }
        __syncthreads();
#pragma unroll
        for (int i = 0; i < 4; ++i) {
            const int c = tid + 512 * i, s = c >> 4, c8 = c & 15;
            const v4u raw = *(const v4u*)(VA + (size_t)(T0 + s) * TOKW + g * 128 + c8 * 8);
            const float mean = lst[2 * s], rstd = lst[2 * s + 1];
            const v4f g0 = *(const v4f*)(lng + g * 128 + c8 * 8), g1 = *(const v4f*)(lng + g * 128 + c8 * 8 + 4), b0 = *(const v4f*)(lnb + g * 128 + c8 * 8), b1 = *(const v4f*)(lnb + g * 128 + c8 * 8 + 4);
            const v4f x0 = (v4f){bf_lo(raw.x), bf_hi(raw.x), bf_lo(raw.y), bf_hi(raw.y)}, x1 = (v4f){bf_lo(raw.z), bf_hi(raw.z), bf_lo(raw.w), bf_hi(raw.w)};
            const v4f y0 = (x0 - mean) * rstd * g0 + b0, y1 = (x1 - mean) * rstd * g1 + b1;
            const unsigned p0 = pk2(y0[0], y0[1]), p1 = pk2(y0[2], y0[3]), p2 = pk2(y1[0], y1[1]), p3 = pk2(y1[2], y1[3]);
            LAS bf16* d = vT + (c8 * 8) * VP + s;
            d[0 * VP] = (bf16)(p0 & 0xffffu); d[1 * VP] = (bf16)(p0 >> 16); d[2 * VP] = (bf16)(p1 & 0xffffu); d[3 * VP] = (bf16)(p1 >> 16);
            d[4 * VP] = (bf16)(p2 & 0xffffu); d[5 * VP] = (bf16)(p2 >> 16); d[6 * VP] = (bf16)(p3 & 0xffffu); d[7 * VP] = (bf16)(p3 >> 16);
        }
        __syncthreads();
        const int t = 16 * w + (lane & 15), kq = lane >> 4;
        const bf16* wrow = WS_ + ((size_t)g * 128 + t) * 128 + 8 * kq;
        v8s wf[4];
#pragma unroll
        for (int ks = 0; ks < 4; ++ks) wf[ks] = *(const v8s*)(wrow + 32 * ks);
        const float bias = bs[g * 128 + t];
        const int nks = (w >> 1) + 1;
#pragma unroll
        for (int ibp = 0; ibp < 4; ++ibp) {
            const int ib0 = 2 * ibp;
            v4f acc0 = (v4f){0.f, 0.f, 0.f, 0.f}, acc1 = acc0;
#pragma unroll
            for (int ks = 0; ks < 4; ++ks) if (ks < nks) {
                const v8s af0 = *(const LAS v8s*)(vT + (16 * ib0 + (lane & 15)) * VP + 32 * ks + 8 * kq);
                const v8s af1 = *(const LAS v8s*)(vT + (16 * ib0 + 16 + (lane & 15)) * VP + 32 * ks + 8 * kq);
                acc0 = __builtin_amdgcn_mfma_f32_16x16x32_bf16(af0, wf[ks], acc0, 0, 0, 0);
                acc1 = __builtin_amdgcn_mfma_f32_16x16x32_bf16(af1, wf[ks], acc1, 0, 0, 0);
            }
            const size_t tok = (size_t)(T0 + t);
            const int cpos = g * 128 + 16 * (ib0 + (kq & 1)) + 4 * (kq & 2);
            const v4u ul = *(const v4u*)(U + tok * TOKW + cpos);
            unsigned ax = ul.x, ay = ul.y, bx = ul.z, by = ul.w;
            { const auto rx = __builtin_amdgcn_permlane16_swap(ax, bx, false, false); ax = rx[0]; bx = rx[1];
              const auto ry = __builtin_amdgcn_permlane16_swap(ay, by, false, false); ay = ry[0]; by = ry[1]; }
            unsigned ox0 = pk2b(bf_lo(ax) * (acc0[0] + bias), bf_hi(ax) * (acc0[1] + bias)), oy0 = pk2b(bf_lo(ay) * (acc0[2] + bias), bf_hi(ay) * (acc0[3] + bias));
            unsigned ox1 = pk2b(bf_lo(bx) * (acc1[0] + bias), bf_hi(bx) * (acc1[1] + bias)), oy1 = pk2b(bf_lo(by) * (acc1[2] + bias), bf_hi(by) * (acc1[3] + bias));
            { const auto rx = __builtin_amdgcn_permlane16_swap(ox0, ox1, false, false); ox0 = rx[0]; ox1 = rx[1];
              const auto ry = __builtin_amdgcn_permlane16_swap(oy0, oy1, false, false); oy0 = ry[0]; oy1 = ry[1]; }
            v4u ov; ov.x = ox0; ov.y = oy0; ov.z = ox1; ov.w = oy1;
            *(v4u*)(MIX + tok * DM + cpos) = ov;
        }
        __syncthreads();
    }
}

template <int DQK, bool CAUSAL>
__device__ __forceinline__ void attn_unit(LAS unsigned char* lds, const bf16* Qp, int qpitch, const bf16* Kp, int kpitch, const bf16* KRp,
                                          const bf16* VTp  , bf16* Op, int opitch, int ntiles, int q0, unsigned* qctr, unsigned& pre) {
    constexpr int KP = DQK + 8, VP = 72, KBYTES = 64 * KP * 2, VBYTES = 128 * VP * 2, NS = DQK / 16;
    int tid = threadIdx.x; asm volatile("" : "+v"(tid));
    const int lane = tid & 63, w = __builtin_amdgcn_readfirstlane(tid >> 6), r = lane & 31, hh = lane >> 5;
    LAS unsigned char* Kb = lds; LAS unsigned char* Vb = lds + 2 * KBYTES;
    v8s qf[NS];
    { const bf16* qrow = Qp + (size_t)(32 * w + r) * qpitch + 8 * hh;
#pragma unroll
      for (int s = 0; s < NS; ++s) qf[s] = *(const v8s*)(qrow + 16 * s); }
    v16f o[4];
#pragma unroll
    for (int i = 0; i < 4; ++i)
#pragma unroll
        for (int j = 0; j < 16; ++j) o[i][j] = 0.f;
    float m_ref = 0.f, l_run = 0.f;
    v4u kreg[3], vreg[2];
    const int kkey = tid >> 4, kc8 = tid & 15;
    const int rkey = tid >> 3, rc8 = tid & 7;
    const int vdv = tid >> 3, vkc = tid & 7;
#define ATT_LOAD(t) do { \
        _Pragma("unroll") for (int i = 0; i < 2; ++i) kreg[i] = *(const v4u*)(Kp + (size_t)((t) * 64 + kkey + 32 * i) * kpitch + kc8 * 8); \
        if (DQK == 192) kreg[2] = *(const v4u*)(KRp + (size_t)((t) * 64 + rkey) * 64 + rc8 * 8); \
        _Pragma("unroll") for (int i = 0; i < 2; ++i) vreg[i] = *(const v4u*)(VTp + (size_t)(t) * 8192 + (tid + 512 * i) * 8); } while (0)
#define ATT_WRITE(b) do { \
        _Pragma("unroll") for (int i = 0; i < 2; ++i) *(LAS v4u*)(Kb + (b) * KBYTES + (kkey + 32 * i) * (KP * 2) + kc8 * 16) = kreg[i]; \
        if (DQK == 192) *(LAS v4u*)(Kb + (b) * KBYTES + rkey * (KP * 2) + 256 + rc8 * 16) = kreg[2]; \
        _Pragma("unroll") for (int i = 0; i < 2; ++i) *(LAS v4u*)(Vb + (b) * VBYTES + (vdv + 64 * i) * (VP * 2) + vkc * 16) = vreg[i]; } while (0)
    ATT_LOAD(0); ATT_WRITE(0);
    if (ntiles > 1) ATT_LOAD(1);
    asm volatile("s_waitcnt lgkmcnt(0)" ::: "memory"); __builtin_amdgcn_s_barrier(); asm volatile("" ::: "memory");
    for (int t = 0; t < ntiles; ++t) {
        const int b = t & 1;
        if (t + 1 < ntiles) { ATT_WRITE(b ^ 1); if (t + 2 < ntiles) ATT_LOAD(t + 2); }
        if (t == ntiles - 1 && threadIdx.x == 0) pre = atomicAdd(qctr, 1u);
        const bool active = !CAUSAL || (t * 64 <= q0 + 32 * w + 31);
        if (active) {
            constexpr int BS = NS / 4;
            const LAS unsigned char* kp0 = Kb + b * KBYTES + r * (KP * 2) + hh * 16;
            const LAS unsigned char* vp0 = Vb + b * VBYTES + r * (VP * 2) + hh * 8;
            const bool need_mask = CAUSAL && (t * 64 + 63 > q0 + 32 * w);
            const int qi = q0 + 32 * w + r - t * 64 - 4 * hh;
            v16f sa0, sa1;
            const v16f zero16 = {0.f, 0.f, 0.f, 0.f, 0.f, 0.f, 0.f, 0.f, 0.f, 0.f, 0.f, 0.f, 0.f, 0.f, 0.f, 0.f};
            v8s kx[2][BS], vx[2][2];
            unsigned pw0[8], pw1[8];
            float rs0 = 0.f, rs1 = 0.f;
#define ATT_SB() __builtin_amdgcn_sched_barrier(0)
#define ATT_LDK(dst, kb, q) do { _Pragma("unroll") for (int i = 0; i < BS; ++i) dst[i] = *(const LAS v8s*)(kp0 + (kb) * (32 * KP * 2) + ((q) * BS + i) * 32); } while (0)
#define ATT_MMK(accv, src, q) do { __builtin_amdgcn_s_setprio(1); _Pragma("unroll") for (int i = 0; i < BS; ++i) accv = __builtin_amdgcn_mfma_f32_32x32x16_bf16(src[i], qf[(q) * BS + i], ((q) == 0 && i == 0) ? zero16 : accv, 0, 0, 0); __builtin_amdgcn_s_setprio(0); } while (0)
#define ATT_EXPC(sav, c, rsv_, pw) do { const float p0_ = __builtin_amdgcn_exp2f(sav[4 * (c)] - m_ref), p1_ = __builtin_amdgcn_exp2f(sav[4 * (c) + 1] - m_ref), p2_ = __builtin_amdgcn_exp2f(sav[4 * (c) + 2] - m_ref), p3_ = __builtin_amdgcn_exp2f(sav[4 * (c) + 3] - m_ref); \
                rsv_ += (p0_ + p1_) + (p2_ + p3_); pw[2 * (c)] = pk2b(p0_, p1_); pw[2 * (c) + 1] = pk2b(p2_, p3_); } while (0)
#define ATT_MASK(sav, kb) do { if (need_mask) { _Pragma("unroll") for (int j = 0; j < 16; ++j) { if (32 * (kb) + (j & 3) + 8 * (j >> 2) > qi) sav[j] = -1e30f; } } } while (0)
#define ATT_LDV(dst, db, pr) do { _Pragma("unroll") for (int i = 0; i < 2; ++i) { const int s_ = (pr) * 2 + i; const v2u lo = *(const LAS v2u*)(vp0 + (db) * (32 * VP * 2) + s_ * 32), hi = *(const LAS v2u*)(vp0 + (db) * (32 * VP * 2) + s_ * 32 + 16); \
                v4u av; av.x = lo.x; av.y = lo.y; av.z = hi.x; av.w = hi.y; dst[i] = __builtin_bit_cast(v8s, av); } } while (0)
#define ATT_MMV(db, src, pwv) do { _Pragma("unroll") for (int i = 0; i < 2; ++i) { v4u pv_; pv_.x = pwv[4 * i]; pv_.y = pwv[4 * i + 1]; pv_.z = pwv[4 * i + 2]; pv_.w = pwv[4 * i + 3]; \
                __builtin_amdgcn_s_setprio(1); o[db] = __builtin_amdgcn_mfma_f32_32x32x16_bf16(src[i], __builtin_bit_cast(v8s, pv_), o[db], 0, 0, 0); __builtin_amdgcn_s_setprio(0); } } while (0)
#define ATT_FIX(sav, other_too, forced, rsv_, pw) do { if (__builtin_amdgcn_ballot_w64((forced) || !(rsv_ < 1e12f)) != 0ull) { \
                float mx = sav[0]; _Pragma("unroll") for (int j = 1; j < 16; ++j) mx = fmaxf(mx, sav[j]); mx = fmaxf(mx, __shfl_xor(mx, 32)) - m_ref; \
                const float delta = (forced) ? mx : fmaxf(mx, 0.f); const float alpha = (forced) ? 1.f : __builtin_amdgcn_exp2f(-delta); \
                m_ref += delta; \
                l_run *= alpha; _Pragma("unroll") for (int i = 0; i < 4; ++i) o[i] = o[i] * alpha; \
                rsv_ = 0.f; ATT_EXPC(sav, 0, rsv_, pw); ATT_EXPC(sav, 1, rsv_, pw); ATT_EXPC(sav, 2, rsv_, pw); ATT_EXPC(sav, 3, rsv_, pw); } } while (0)
            ATT_LDK(kx[0], 0, 0); ATT_SB();
            ATT_LDK(kx[1], 0, 1); ATT_SB(); ATT_MMK(sa0, kx[0], 0); ATT_SB();
            ATT_LDK(kx[0], 0, 2); ATT_SB(); ATT_MMK(sa0, kx[1], 1); ATT_SB();
            ATT_LDK(kx[1], 0, 3); ATT_SB(); ATT_MMK(sa0, kx[0], 2); ATT_SB();
            ATT_LDK(kx[0], 1, 0); ATT_SB(); ATT_MMK(sa0, kx[1], 3); ATT_SB();
            ATT_MASK(sa0, 0); ATT_SB();
            ATT_LDK(kx[1], 1, 1); ATT_SB(); ATT_MMK(sa1, kx[0], 0); ATT_EXPC(sa0, 0, rs0, pw0); ATT_SB();
            ATT_LDK(kx[0], 1, 2); ATT_SB(); ATT_MMK(sa1, kx[1], 1); ATT_EXPC(sa0, 1, rs0, pw0); ATT_SB();
            ATT_LDK(kx[1], 1, 3); ATT_SB(); ATT_MMK(sa1, kx[0], 2); ATT_EXPC(sa0, 2, rs0, pw0); ATT_SB();
            ATT_LDV(vx[0], 0, 0); ATT_SB(); ATT_MMK(sa1, kx[1], 3); ATT_EXPC(sa0, 3, rs0, pw0); ATT_SB();
            ATT_MASK(sa1, 1);
            ATT_FIX(sa0, true, t == 0, rs0, pw0);
            l_run += rs0; ATT_SB();
            ATT_LDV(vx[1], 1, 0); ATT_SB(); ATT_MMV(0, vx[0], pw0); ATT_EXPC(sa1, 0, rs1, pw1); ATT_SB();
            ATT_LDV(vx[0], 2, 0); ATT_SB(); ATT_MMV(1, vx[1], pw0); ATT_EXPC(sa1, 1, rs1, pw1); ATT_SB();
            ATT_LDV(vx[1], 3, 0); ATT_SB(); ATT_MMV(2, vx[0], pw0); ATT_EXPC(sa1, 2, rs1, pw1); ATT_SB();
            ATT_LDV(vx[0], 0, 1); ATT_SB(); ATT_MMV(3, vx[1], pw0); ATT_EXPC(sa1, 3, rs1, pw1); ATT_SB();
            ATT_FIX(sa1, false, false, rs1, pw1);
            l_run += rs1; ATT_SB();
            ATT_LDV(vx[1], 1, 1); ATT_SB(); ATT_MMV(0, vx[0], pw1); ATT_SB();
            ATT_LDV(vx[0], 2, 1); ATT_SB(); ATT_MMV(1, vx[1], pw1); ATT_SB();
            ATT_LDV(vx[1], 3, 1); ATT_SB(); ATT_MMV(2, vx[0], pw1); ATT_SB();
            ATT_MMV(3, vx[1], pw1); ATT_SB();
#undef ATT_SB
#undef ATT_LDK
#undef ATT_MMK
#undef ATT_EXPC
#undef ATT_MASK
#undef ATT_LDV
#undef ATT_MMV
#undef ATT_FIX
        }
        asm volatile("s_waitcnt lgkmcnt(0)" ::: "memory"); __builtin_amdgcn_s_barrier(); asm volatile("" ::: "memory");
    }
#undef ATT_LOAD
#undef ATT_WRITE
    const float ltot = l_run + __shfl_xor(l_run, 32);
    const float inv = 1.0f / ltot;
    bf16* orow = Op + (size_t)(32 * w + r) * opitch + 8 * hh;
#pragma unroll
    for (int db = 0; db < 4; ++db)
#pragma unroll
        for (int gp = 0; gp < 2; ++gp) {
            const int g = 2 * gp;
            unsigned ax = pk2b(o[db][4 * g] * inv, o[db][4 * g + 1] * inv), ay = pk2b(o[db][4 * g + 2] * inv, o[db][4 * g + 3] * inv);
            unsigned bx = pk2b(o[db][4 * g + 4] * inv, o[db][4 * g + 5] * inv), by = pk2b(o[db][4 * g + 6] * inv, o[db][4 * g + 7] * inv);
            const auto rx = __builtin_amdgcn_permlane32_swap(ax, bx, false, false); ax = rx[0]; bx = rx[1];
            const auto ry = __builtin_amdgcn_permlane32_swap(ay, by, false, false); ay = ry[0]; by = ry[1];
            v4u ov; ov.x = ax; ov.y = ay; ov.z = bx; ov.w = by;
            *(v4u*)(orow + 32 * db + 16 * gp) = ov;
        }
}

__device__ __forceinline__ unsigned my_xcc_id() { return (unsigned)__builtin_amdgcn_s_getreg((3 << 11) | 20) & 7u; }
__device__ __forceinline__ void attn_phase(const Args& a, LAS unsigned char* lds, bool layerB, int rep) {
    unsigned char* ws = a.ws;
    unsigned* qbase = (unsigned*)(ws + WS_CTL) + CTL_QUEUE + (layerB ? 128 : 0) + 256 * rep;
    volatile LAS unsigned* slot = (volatile LAS unsigned*)(lds + LDS_MISC);
    const int ncausal = layerB ? 96 : 0, total = ncausal + 32;
    bf16* MIX = (bf16*)(ws + (layerB ? WS_MIXB : WS_MIXA));
    const bf16* MQ = (const bf16*)(ws + (layerB ? WS_MQB : WS_MQ));
    const unsigned myx = my_xcc_id();
    for (int k = 0; k < 8; ++k) {
        const int x = (int)((myx + k) & 7u);
        unsigned* qctr = qbase + 16 * x;
        __syncthreads();
        if (threadIdx.x == 0) slot[0] = atomicAdd(qctr, 1u);
        __syncthreads();
        int idx = (int)slot[0];
        while (idx < total) {
            unsigned pre = 0u;
            if (idx < ncausal) {
                const int qb = 15 - idx / 6, bh = x + 8 * (idx % 6), b = bh / 12, h = bh % 12;
                const size_t tok0 = (size_t)b * SEQ;
                attn_unit<192, true>(lds, (const bf16*)(ws + WS_Q) + (tok0 + 256 * qb) * 2304 + h * 192, 2304,
                                     (const bf16*)(ws + WS_KN) + tok0 * 1536 + h * 128, 1536, (const bf16*)(ws + WS_KR) + tok0 * 64,
                                     (const bf16*)(ws + WS_VT) + (size_t)(h * 256 + b * 64) * 8192,
                                     MIX + (tok0 + 256 * qb) * DM + h * 128, DM, 4 * (qb + 1), 256 * qb, qctr, pre);
            } else {
                const int mi = x * 32 + (idx - ncausal), qblk = mi >> 2, h = mi & 3, b = qblk >> 4, l = layerB ? 1 : 0;
                const size_t row0 = (size_t)qblk * 256;
                attn_unit<128, false>(lds, MQ + row0 * 512 + h * 128, 512,
                                      (const bf16*)(ws + WS_KMEM) + (size_t)(b * 256) * 1024 + l * 512 + h * 128, 1024, nullptr,
                                      (const bf16*)(ws + WS_VMT) + (size_t)((l * 4 + h) * 16 + b * 4) * 8192,
                                      MIX + row0 * DM + TOKW + h * 128, DM, 4, 0, qctr, pre);
            }
            if (threadIdx.x == 0) slot[0] = pre;
            __syncthreads();
            idx = (int)slot[0];
        }
    }
}

#define XB_TMO      128
#define XB_XCNT(j)  (256  + 64 * (j))
#define XB_XSUB(j)  (1280 + 64 * (j))
#define XB_XGEN(j)  (2304 + 64 * (j))
#define XB_TOP      3328
#define XB_TOPGEN   3392
#define XCD_BAR_WORDS 3456
#define XB_SPIN_CAP (1u << 18)

__device__ __forceinline__ unsigned xb_ld(unsigned* p)              { return __hip_atomic_load(p, __ATOMIC_RELAXED, __HIP_MEMORY_SCOPE_AGENT); }
__device__ __forceinline__ unsigned xb_add(unsigned* p, unsigned v) { return __hip_atomic_fetch_add(p, v, __ATOMIC_RELAXED, __HIP_MEMORY_SCOPE_AGENT); }
__device__ __forceinline__ unsigned xb_xcc_id() { return (unsigned)__builtin_amdgcn_s_getreg((3 << 11) | 20) & 0xFu; }
#define XB_SPIN(cond, bar) do { unsigned _sp = 0; while (cond) { __builtin_amdgcn_s_sleep(1); \
    if ((++_sp & 255u) == 0u) { if (xb_ld(&(bar)[XB_TMO])) break; if (_sp > XB_SPIN_CAP) { atomicAdd(&(bar)[XB_TMO], 1u); break; } } } } while (0)

struct XcdBarrier {
    unsigned* bar; unsigned x;
    volatile LAS unsigned* st;
};

__device__ __forceinline__ XcdBarrier xcd_barrier_post(unsigned* bar, volatile LAS unsigned* st) {
    XcdBarrier b; b.bar = bar; b.x = xb_xcc_id(); b.st = st;
    if (threadIdx.x == 0) (void)xb_add(&bar[XB_XCNT(b.x)], 1u);
    return b;
}
__device__ __forceinline__ void xcd_barrier_complete(unsigned* bar, unsigned x, unsigned& nloc, unsigned& nx) {
    const unsigned G = gridDim.x * gridDim.y * gridDim.z;
    unsigned sum, cnt, mine, sp = 0u;
    for (;;) {
        sum = 0u; cnt = 0u; mine = 0u;
#pragma unroll
        for (unsigned j = 0; j < 16; ++j) { const unsigned c = xb_ld(&bar[XB_XCNT(j)]); sum += c; cnt += (c > 0u) ? 1u : 0u; mine = (j == x) ? c : mine; }
        if (sum == G) break;
        __builtin_amdgcn_s_sleep(1);
        if ((++sp & 255u) == 0u) { if (xb_ld(&bar[XB_TMO])) break; if (sp > XB_SPIN_CAP) { atomicAdd(&bar[XB_TMO], 1u); break; } }
    }
    nloc = mine > 0u ? mine : 1u; nx = cnt > 0u ? cnt : 1u;
}

__device__ __forceinline__ void xcd_barrier(const XcdBarrier& b) {
    asm volatile("s_waitcnt vmcnt(0)" ::: "memory");
    __syncthreads();
    if (threadIdx.x == 0) {
        unsigned* bar = b.bar;
        __builtin_amdgcn_s_waitcnt(0);
        unsigned nloc = b.st[0], nx = b.st[1];
        if (nloc == 0u) { xcd_barrier_complete(bar, b.x, nloc, nx); b.st[0] = nloc; b.st[1] = nx; }
        const unsigned old = xb_add(&bar[XB_XSUB(b.x)], 1u);
        const unsigned gen = old / nloc;
        if (old + 1u == (gen + 1u) * nloc) {
            __builtin_amdgcn_fence(__ATOMIC_RELEASE, "agent");
            asm volatile("s_waitcnt vmcnt(0)" ::: "memory");
            const unsigned og = xb_add(&bar[XB_TOP], 1u);
            const unsigned tg = og / nx;
            if (og + 1u == (tg + 1u) * nx) xb_add(&bar[XB_TOPGEN], 1u);
            else XB_SPIN(xb_ld(&bar[XB_TOPGEN]) == tg, bar);
            __builtin_amdgcn_fence(__ATOMIC_ACQUIRE, "agent");
            xb_add(&bar[XB_XGEN(b.x)], 1u);
            asm volatile("s_waitcnt vmcnt(0)" ::: "memory");
        } else {
            XB_SPIN(xb_ld(&bar[XB_XGEN(b.x)]) == gen, bar);
            __builtin_amdgcn_fence(__ATOMIC_ACQUIRE, "agent");
            asm volatile("s_waitcnt vmcnt(0)" ::: "memory");
        }
    }
    __syncthreads();
}

__device__ __forceinline__ void tile_of(int nM, int nN, int wg, pg8::Unit& u) {
    const int nwg = nM * nN, q = nwg / 8, r = nwg % 8, xcd = wg % 8, off = wg / 8;
    wg = (xcd < r ? xcd * (q + 1) : r * (q + 1) + (xcd - r) * q) + off;
    const int nig = 8 * nN, gid = wg / nig, fm = gid * 8, gsz = (nM - fm) < 8 ? (nM - fm) : 8;
    u.pm = fm + ((wg % nig) % gsz); u.pn = (wg % nig) / gsz;
}
struct Order {
    pg8::StaticOrder s; int mode, G, c;
    __device__ __forceinline__ bool next(int i, pg8::Unit& u) const {
        if (mode == 0) return s.next(i, u);
        const int L = i * G + c;
        if (L < 384) { tile_of(64, 6, L, u); u.pm += VT_CKV; u.pn += VT_WUK; return true; }
        if (L < 768) { tile_of(6, 64, L - 384, u); u.pm += VT_WUV; u.pn += VT_CKV; return true; }
        if (L < 1344) { tile_of(64, 9, L - 768, u); u.pm += VT_ZQ; u.pn += VT_WUQ; return true; }
        return false;
    }
    __device__ __forceinline__ void a_ready(const pg8::Unit&) const {}
    __device__ __forceinline__ void done(const pg8::Unit&) const {}
};

__device__ __forceinline__ bool gemm_job(const Args& a, int p, int j, pg8::Gemm& g, Epi& E, int& rot) {
    unsigned char* ws = a.ws; float* ctl = (float*)(ws + WS_ST);
    E.kind = EK_STORE; E.scale_mode = 0; E.accss = 0; E.ldc = DM; E.o0 = nullptr; E.ssin = nullptr; E.inv_n = 0.f; E.ss0 = nullptr; E.nslots = 32; E.vt_nt = 0; E.wsb = ws; E.pm_cached = -1; E.lrs = nullptr; rot = 0;
#define BF(off) ((bf16*)(ws + (off)))
    switch (p) {
    case 1:
        if (j == 0) { g = pg8::Gemm{BF(WS_HN), BF(WS_WAIN), NTOK, 3584, 2048}; E.kind = EK_AIN; return true; }
        if (j == 1) { g = pg8::Gemm{BF(WS_MEMN), BF(WS_WMK), 1024, 1024, 2048}; E.o0 = BF(WS_KMEM); E.ldc = 1024; rot = 128; return true; }
        if (j == 2) { g = pg8::Gemm{BF(WS_WMV), BF(WS_MEMN), 1024, 1024, 2048}; E.o0 = BF(WS_VMT); E.ldc = 1024; E.vt_nt = 16; rot = 112; return true; }
        return false;
    case 3: case 11:
        if (j == 0) { g = pg8::Gemm{BF(p == 3 ? WS_MIXA : WS_MIXB), BF(p == 3 ? WS_WAOUT : WS_WBOUT), NTOK, DM, DM}; E.o0 = BF(WS_GOUT); E.accss = 1; E.ss0 = ctl + ST_G; return true; }
        return false;
    case 5: case 13:
        if (j == 0) { g = pg8::Gemm{BF(WS_HN), BF(p == 13 ? WS_WGU1 : WS_WGU0), NTOK, 11264, 2048}; E.kind = EK_GATEUP; E.o0 = BF(WS_ACT); return true; }
        return false;
    case 6: case 14:
        if (j == 0) { g = pg8::Gemm{BF(WS_ACT), BF(p == 14 ? WS_WDN1 : WS_WDN0), NTOK, DM, DFF}; E.o0 = BF(WS_GOUT); E.accss = 1; E.ss0 = ctl + ST_G; return true; }
        return false;
    case 8:
        if (j == 0) { g = pg8::Gemm{BF(WS_HN), BF(WS_WBIN), NTOK, 1792, 2048}; E.kind = EK_BIN; return true; }
        return false;
    case 9:
        if (j == 0) { g = pg8::Gemm{BF(0), BF(0), 256, 256, 512}; E.kind = EK_P9; E.inv_n = 1.f / 512.f; rot = -1; return true; }
        return false;
    default: return false;
    }
#undef BF
}

#ifndef PROBE_REP
#define PROBE_REP (-1)
#endif
__global__ void __launch_bounds__(512, 2) yoco_fwd(Args a) {
    extern __shared__ __attribute__((aligned(16))) unsigned char lds_raw[];
    LAS unsigned char* lds = (LAS unsigned char*)lds_raw;
    cg::grid_group grid = cg::this_grid();
    unsigned char* ws = a.ws; const float* ng = a.in[3];
    volatile LAS unsigned* misc = (volatile LAS unsigned*)(lds + LDS_MISC);
    if (threadIdx.x < 16) misc[threadIdx.x] = 0u;
    __syncthreads();
    XcdBarrier bar = xcd_barrier_post((unsigned*)(ws + WS_CTL) + CW_BAR, misc + 8);
    for (int p = a.ph_lo; p < a.ph_hi; ++p) {
        const int nrep = (p == PROBE_REP) ? 2 : 1;
        for (int rp = 0; rp < nrep; ++rp) {
            if (rp) xcd_barrier(bar);
            if (p == 0) prologue(a, lds);
            else if (p == 2 || p == 10) { if (p == 2) gating_phase(a, lds); attn_phase(a, lds, p == 10, rp); }
            else if (p == 4 || p == 7 || p == 12 || p == 15) {
                const float* ss = (const float*)(ws + WS_ST) + ST_G;
                const float* gain = ng + (p == 4 ? 1 : (p == 7 ? 3 : (p == 12 ? 5 : 7))) * 2048;
                rowpass(p == 4 ? a.in[0] : nullptr, (bf16*)(ws + WS_HN), (const bf16*)(ws + WS_GOUT), ss, gain, (float*)(ws + WS_HSS), p == 15 ? a.out : nullptr);
            } else {
                for (int j = 0;; ++j) {
                    pg8::Gemm g; Epi E; int rot;
                    if (!gemm_job(a, p, j, g, E, rot)) break;
                    Order S; S.mode = rot < 0 ? 1 : 0; S.G = (int)gridDim.x; S.c = (int)blockIdx.x; if (rot < 0) rot = 0;
                    S.s.init(g.M, g.N, (int)gridDim.x, (int)((blockIdx.x + rot) % gridDim.x));
                    if (E.kind == EK_GATEUP || E.kind == EK_BIN) {
                        pg8::Unit u0; LAS float* lrs = (LAS float*)(lds + LDS_MISC + 1024);
                        if (S.next(0, u0)) { if (threadIdx.x < 256) lrs[threadIdx.x] = __builtin_amdgcn_rsqf(((const float*)(ws + WS_HSS))[u0.pm * 256 + threadIdx.x] * (1.f / DM) + EPS); E.pm_cached = u0.pm; E.lrs = lrs; }
                        __syncthreads();
                    }
                    pg8::gemm_phase<Epi, Order, true, true>(lds, g, S, E);
                }
            }
        }
        if (p + 1 < a.ph_hi) { if (p == 0) grid.sync(); else xcd_barrier(bar); }
    }
}

extern "C" void kernel_launch(void* const* d_in, const int* in_sizes, int n_in, void* d_out, int out_size, void* d_ws, size_t ws_size, hipStream_t stream) {
    static int grid = 0;
    if (grid == 0) {
        if (n_in != 24 || out_size != NTOK * DM || ws_size < WS_END) { fprintf(stderr, "kernel_launch: unexpected shapes (n_in %d out %d ws %zu)\n", n_in, out_size, ws_size); grid = -1; return; }
        int dev = 0, cus = 0, per_cu = 0;
        hipGetDevice(&dev); hipDeviceGetAttribute(&cus, hipDeviceAttributeMultiprocessorCount, dev);
        if (hipFuncSetAttribute((const void*)yoco_fwd, hipFuncAttributeMaxDynamicSharedMemorySize, LDS_BYTES) != hipSuccess) { fprintf(stderr, "kernel_launch: hipFuncSetAttribute failed\n"); grid = -1; return; }
        hipOccupancyMaxActiveBlocksPerMultiprocessor(&per_cu, (const void*)yoco_fwd, 512, LDS_BYTES);
        (void)hipGetLastError();
        if (per_cu < 1) per_cu = 1;
        grid = cus * per_cu;
        fprintf(stderr, "kernel_launch: grid %d (%d CUs x %d)\n", grid, cus, per_cu);
    }
    if (grid < 0) return;
    if (hipMemsetAsync((char*)d_ws + WS_CTL, 0, CTL_ZERO_BYTES, stream) != hipSuccess) { fprintf(stderr, "kernel_launch: memset failed\n"); return; }
    Args a{};
    for (int i = 0; i < 24; ++i) a.in[i] = (const float*)d_in[i];
    a.out = (float*)d_out; a.ws = (unsigned char*)d_ws;
#ifndef N_CUTS
    a.ph_lo = 0; a.ph_hi = 16;
    void* args[] = {&a};
    hipError_t e = hipLaunchCooperativeKernel((const void*)yoco_fwd, dim3(grid), dim3(512), args, LDS_BYTES, stream);
    if (e != hipSuccess) fprintf(stderr, "cooperative launch failed: %s (grid %d)\n", hipGetErrorString(e), grid);
#else
    for (int p = 0; p < 16; ++p) { a.ph_lo = p; a.ph_hi = p + 1; void* args[] = {&a};
        hipError_t e = hipLaunchCooperativeKernel((const void*)yoco_fwd, dim3(grid), dim3(512), args, LDS_BYTES, stream);
        if (e != hipSuccess) { fprintf(stderr, "launch %d failed: %s\n", p, hipGetErrorString(e)); break; } }
#endif
}
```

```cpp
#include <hip/hip_runtime.h>
#include <hip/hip_cooperative_groups.h>
#include <cstdio>
#include <cstdint>
namespace cg = cooperative_groups;
namespace pg8 {
#define PG8_LAS __attribute__((address_space(3)))
typedef unsigned short bf16_t;
typedef short bf16x8 __attribute__((ext_vector_type(8)));
typedef float f32x4 __attribute__((ext_vector_type(4)));
typedef unsigned u32x4 __attribute__((ext_vector_type(4)));
constexpr int BM = 256, BK = 64, HALF = 128, HTB = HALF * BK * 2  , STAGE_BYTES = 8 * HTB, NXCD = 8, WGM = 8;

__host__ __device__ __forceinline__ int lds_byte(int r, int c) { const int st = (r >> 4) * 2 + (c >> 5), rr = r & 15, cc = c & 31, ob = rr * 64 + cc * 2; return st * 1024 + (ob ^ (((ob >> 9) & 1) << 5)); }
__host__ __device__ __forceinline__ void stage_rc(int b, int& R, int& C) { const int st = b / 1024, sb = b % 1024, swz = sb ^ (((sb >> 9) & 1) << 5); R = (st >> 1) * 16 + swz / 64; C = (st & 1) * 32 + (swz % 64) / 2; }
__host__ __device__ __forceinline__ int perm32(int rho) { const int n = rho >> 4, i = rho & 15; return 8 * (i >> 2) + 4 * n + (i & 3); }

struct Unit { int pm, pn; };
struct Gemm { const bf16_t* A; const bf16_t* Bt; int M, N, K; };

struct StaticOrder {
    int nM, nN, nwg, G, c;
    __host__ __device__ void init(int M, int N, int G_, int c_) { nM = M / BM; nN = N / BM; nwg = nM * nN; G = G_; c = c_; }
    __host__ __device__ bool next(int i, Unit& u) const {
        const long L = (long)i * G + c; if (L >= nwg) return false;
        int wgid = (int)L; { const int q = nwg / NXCD, r = nwg % NXCD, xcd = wgid % NXCD, off = wgid / NXCD; wgid = (xcd < r ? xcd * (q + 1) : r * (q + 1) + (xcd - r) * q) + off; }
        const int nig = WGM * nN, gid = wgid / nig, fm = gid * WGM, gsz = (nM - fm) < WGM ? (nM - fm) : WGM;
        u.pm = fm + ((wgid % nig) % gsz); u.pn = (wgid % nig) / gsz; return true;
    }
    __device__ __forceinline__ void a_ready(const Unit&) const {}
    __device__ __forceinline__ void done(const Unit&) const {}
};

__device__ __forceinline__ unsigned cvt_pk_bf16(float lo, float hi) { unsigned r; asm volatile("v_cvt_pk_bf16_f32 %0, %1, %2" : "=v"(r) : "v"(lo), "v"(hi)); return r; }
template <class Epi, class Sched, bool ALIGN_EPI = false, bool SP2 = false>
__device__ __forceinline__ void gemm_phase(PG8_LAS unsigned char* lds, const Gemm g, const Sched& S, const Epi& E) {
    int tid_raw = threadIdx.x; asm volatile("" : "+v"(tid_raw));
    const int tid = tid_raw, wid = __builtin_amdgcn_readfirstlane(tid >> 6), lane = tid & 63, wr = wid >> 2, wc = wid & 3, fr = lane & 15, fq = lane >> 4;
    const int K = g.K, nt = K / BK;
    unsigned voffA[2], voffB[2];
#pragma unroll
    for (int i = 0; i < 2; ++i) { int R, C; stage_rc(tid * 16 + i * 8192, R, C); const int Rb = Epi::PERM ? ((R & ~31) + perm32(R & 31)) : R;
        voffA[i] = (unsigned)(R * K + C) * 2u; voffB[i] = (unsigned)(Rb * K + C) * 2u; }
    const size_t kstep = (size_t)(BK * 2);
    const size_t hstep = (size_t)HALF * K * 2;
    const size_t tstep = 2 * hstep;
    const unsigned ldsw = (unsigned)wid * 1024u;
    const int aoff = lds_byte(wr * 64 + fr, fq * 8), boff = lds_byte(wc * 32 + fr, fq * 8);
#define PG8_SA(b, h) (((b) * 2 + (h)) * HTB)
#define PG8_SB(b, h) ((4 + (b) * 2 + (h)) * HTB)
#define PG8_STAGE(bufoff, gbase, voff) do { _Pragma("unroll") for (int _i = 0; _i < 2; ++_i) \
        __builtin_amdgcn_global_load_lds((const unsigned*)((const char*)(gbase) + (voff)[_i]), (PG8_LAS unsigned*)(lds + (bufoff) + ldsw + _i * 8192), 16, 0, 0); } while (0)
#define PG8_LDA(dst, b, h) do { _Pragma("unroll") for (int m = 0; m < 4; ++m) _Pragma("unroll") for (int k = 0; k < 2; ++k) dst[m][k] = *(const PG8_LAS bf16x8*)(lds + PG8_SA(b, h) + aoff + m * 2048 + k * 1024); } while (0)
#define PG8_LDB(dst, b, h) do { _Pragma("unroll") for (int n = 0; n < 2; ++n) _Pragma("unroll") for (int k = 0; k < 2; ++k) dst[n][k] = *(const PG8_LAS bf16x8*)(lds + PG8_SB(b, h) + boff + n * 2048 + k * 1024); } while (0)
#define PG8_MMA(ai, bj, At, Bt) do { __builtin_amdgcn_s_setprio(1); _Pragma("unroll") for (int m = 0; m < 4; ++m) _Pragma("unroll") for (int n = 0; n < 2; ++n) _Pragma("unroll") for (int k = 0; k < 2; ++k) \
        acc[ai][bj][m][n] = __builtin_amdgcn_mfma_f32_16x16x32_bf16(Bt[n][k], At[m][k], acc[ai][bj][m][n], 0, 0, 0); __builtin_amdgcn_s_setprio(0); } while (0)
#define PG8_WAIT_V(n) asm volatile("s_waitcnt vmcnt(" #n ")" ::: "memory")
#define PG8_WAIT_L(n) asm volatile("s_waitcnt lgkmcnt(" #n ")" ::: "memory")
#define PG8_BAR __builtin_amdgcn_s_barrier()
#define PG8_SCHED __builtin_amdgcn_sched_barrier(0)
    Unit cur, nxt; int ui = 0;
    if (!S.next(0, cur)) return;
    f32x4 acc[2][2][4][2];
#pragma unroll
    for (int a = 0; a < 2; ++a)
#pragma unroll
        for (int b = 0; b < 2; ++b)
#pragma unroll
            for (int m = 0; m < 4; ++m)
#pragma unroll
                for (int n = 0; n < 2; ++n) acc[a][b][m][n] = (f32x4){0.f, 0.f, 0.f, 0.f};
    bf16x8 At[4][2], B0[2][2], B1[2][2];
    const char* cA = (const char*)g.A + (size_t)cur.pm * tstep; const char* cB = (const char*)g.Bt + (size_t)cur.pn * tstep;
    S.a_ready(cur);
    if constexpr (SP2) {
        PG8_STAGE(PG8_SB(0, 0), cB, voffB); PG8_STAGE(PG8_SB(0, 1), cB + hstep, voffB); PG8_STAGE(PG8_SA(0, 0), cA, voffA); PG8_STAGE(PG8_SA(0, 1), cA + hstep, voffA);
        if (wr == 1) PG8_BAR;
        PG8_WAIT_V(2); PG8_BAR;
        PG8_STAGE(PG8_SB(1, 0), cB + kstep, voffB); PG8_STAGE(PG8_SA(1, 0), cA + kstep, voffA); PG8_STAGE(PG8_SB(1, 1), cB + hstep + kstep, voffB);
        PG8_WAIT_V(6); PG8_BAR;
    } else {
        PG8_STAGE(PG8_SB(0, 0), cB, voffB); PG8_STAGE(PG8_SA(0, 0), cA, voffA); PG8_STAGE(PG8_SB(0, 1), cB + hstep, voffB); PG8_STAGE(PG8_SA(0, 1), cA + hstep, voffA);
        if (wr == 1) PG8_BAR;
        PG8_WAIT_V(4); PG8_BAR;
        PG8_STAGE(PG8_SB(1, 0), cB + kstep, voffB); PG8_STAGE(PG8_SA(1, 0), cA + kstep, voffA); PG8_STAGE(PG8_SB(1, 1), cB + hstep + kstep, voffB);
        PG8_WAIT_V(6); PG8_BAR;
    }
    for (;;) {
        const bool has_next = S.next(ui + 1, nxt);
        const char* nA = has_next ? (const char*)g.A + (size_t)nxt.pm * tstep : cA; const char* nB = has_next ? (const char*)g.Bt + (size_t)nxt.pn * tstep : cB;
        for (int t = 0; t < nt; t += 2) {
            const bool last = (t == nt - 2);
            const char* a1 = cA + (size_t)(t + 1) * kstep;
            const char* a2 = last ? nA : cA + (size_t)(t + 2) * kstep; const char* b2 = last ? nB : cB + (size_t)(t + 2) * kstep;
            const char* a3 = a2 + kstep; const char* b3 = b2 + kstep;
            if (last && has_next) S.a_ready(nxt);
            if constexpr (SP2) {
            PG8_LDB(B0, 0, 0); PG8_LDB(B1, 0, 1); PG8_SCHED; PG8_LDA(At, 0, 0); PG8_STAGE(PG8_SA(1, 1), a1 + hstep, voffA);
            PG8_WAIT_V(8); PG8_WAIT_L(0); PG8_BAR; PG8_MMA(0, 0, At, B0); PG8_MMA(0, 1, At, B1); PG8_BAR; PG8_SCHED;
            PG8_LDA(At, 0, 1); PG8_STAGE(PG8_SB(0, 0), b2, voffB); PG8_STAGE(PG8_SB(0, 1), b2 + hstep, voffB); PG8_STAGE(PG8_SA(0, 0), a2, voffA);
            PG8_WAIT_V(8); PG8_WAIT_L(0); PG8_BAR; PG8_MMA(1, 0, At, B0); PG8_MMA(1, 1, At, B1); PG8_BAR; PG8_SCHED;
            PG8_LDB(B0, 1, 0); PG8_LDB(B1, 1, 1); PG8_SCHED; PG8_LDA(At, 1, 0); PG8_STAGE(PG8_SA(0, 1), a2 + hstep, voffA);
            PG8_WAIT_V(8); PG8_WAIT_L(0); PG8_BAR; PG8_MMA(0, 0, At, B0); PG8_MMA(0, 1, At, B1); PG8_BAR; PG8_SCHED;
            PG8_LDA(At, 1, 1); PG8_STAGE(PG8_SB(1, 0), b3, voffB); PG8_STAGE(PG8_SB(1, 1), b3 + hstep, voffB); PG8_STAGE(PG8_SA(1, 0), a3, voffA);
            PG8_WAIT_V(8); PG8_WAIT_L(0); PG8_BAR; PG8_MMA(1, 0, At, B0); PG8_MMA(1, 1, At, B1); PG8_BAR; PG8_SCHED;
            } else {
            PG8_LDB(B0, 0, 0); PG8_SCHED; PG8_LDA(At, 0, 0); PG8_STAGE(PG8_SA(1, 1), a1 + hstep, voffA);
            PG8_WAIT_L(8); PG8_BAR; PG8_WAIT_L(0); PG8_MMA(0, 0, At, B0); PG8_BAR; PG8_SCHED;
            PG8_LDB(B1, 0, 1); PG8_STAGE(PG8_SB(0, 0), b2, voffB);
            PG8_BAR; PG8_WAIT_L(0); PG8_MMA(0, 1, At, B1); PG8_BAR;
            PG8_LDA(At, 0, 1); PG8_STAGE(PG8_SA(0, 0), a2, voffA);
            PG8_BAR; PG8_WAIT_L(0); PG8_MMA(1, 0, At, B0); PG8_BAR; PG8_SCHED;
            PG8_STAGE(PG8_SB(0, 1), b2 + hstep, voffB);
            PG8_WAIT_V(6); PG8_BAR; PG8_MMA(1, 1, At, B1); PG8_BAR;
            PG8_LDB(B0, 1, 0); PG8_SCHED; PG8_LDA(At, 1, 0); PG8_STAGE(PG8_SA(0, 1), a2 + hstep, voffA);
            PG8_WAIT_L(8); PG8_BAR; PG8_WAIT_L(0); PG8_MMA(0, 0, At, B0); PG8_BAR; PG8_SCHED;
            PG8_LDB(B1, 1, 1); PG8_STAGE(PG8_SB(1, 0), b3, voffB);
            PG8_BAR; PG8_WAIT_L(0); PG8_MMA(0, 1, At, B1); PG8_BAR;
            PG8_LDA(At, 1, 1); PG8_STAGE(PG8_SA(1, 0), a3, voffA);
            PG8_BAR; PG8_WAIT_L(0); PG8_MMA(1, 0, At, B0); PG8_BAR; PG8_SCHED;
            PG8_STAGE(PG8_SB(1, 1), b3 + hstep, voffB);
            PG8_WAIT_V(6); PG8_BAR; PG8_MMA(1, 1, At, B1); PG8_BAR;
            }
        }
        if constexpr (ALIGN_EPI) { if (wr == 0) PG8_BAR; }
        if constexpr (!Epi::AFTER_DRAIN) { E(acc, cur, wr, wc, fr, fq); S.done(cur); }
        if (!has_next) break;
#pragma unroll
        for (int a = 0; a < 2; ++a)
#pragma unroll
            for (int b = 0; b < 2; ++b)
#pragma unroll
                for (int m = 0; m < 4; ++m)
#pragma unroll
                    for (int n = 0; n < 2; ++n) acc[a][b][m][n] = (f32x4){0.f, 0.f, 0.f, 0.f};
        cur = nxt; cA = nA; cB = nB; ++ui;
        if constexpr (ALIGN_EPI) { if (wr == 1) PG8_BAR; }
    }
    PG8_WAIT_V(0);
    if constexpr (!ALIGN_EPI) { if (wr == 0) PG8_BAR; }
    PG8_BAR;
    if constexpr (Epi::AFTER_DRAIN) { E.fused(acc, cur, wr, wc, fr, fq, lds, wid, lane); S.done(cur); }
#undef PG8_SA
#undef PG8_SB
#undef PG8_STAGE
#undef PG8_LDA
#undef PG8_LDB
#undef PG8_MMA
#undef PG8_WAIT_V
#undef PG8_WAIT_L
#undef PG8_BAR
#undef PG8_SCHED
}
}

#define LAS __attribute__((address_space(3)))
typedef unsigned short bf16;
typedef unsigned v4u __attribute__((ext_vector_type(4)));
typedef unsigned v2u __attribute__((ext_vector_type(2)));
typedef float v4f __attribute__((ext_vector_type(4)));
typedef float v16f __attribute__((ext_vector_type(16)));
typedef short v8s __attribute__((ext_vector_type(8)));

constexpr int NTOK = 16384, DM = 2048, SEQ = 4096, DFF = 5632, TOKW = 1536;
constexpr float EPS = 1e-6f;
constexpr float LOG2E = 1.4426950408889634f;
constexpr float QSCALE_MLA = 0.07216878364870322f * LOG2E, QSCALE_MEM = 0.08838834764831845f * LOG2E;

constexpr size_t MiB = 1u << 20;
constexpr size_t WS_CTL = 0;
constexpr size_t WS_COS = 1 * MiB, WS_SIN = 3 * MiB;
constexpr size_t WS_MEMN = 5 * MiB, WS_KMEM = 9 * MiB, WS_VMT = 11 * MiB, WS_WS = 13 * MiB;
constexpr size_t WS_WAIN = 14 * MiB, WS_WAOUT = 28 * MiB, WS_WGU0 = 36 * MiB, WS_WDN0 = 80 * MiB, WS_MIXB = 14 * MiB;
constexpr size_t WS_WMK = 102 * MiB, WS_WMV = 106 * MiB, WS_WGU1 = 110 * MiB, WS_WDN1 = 154 * MiB, WS_WBIN = 176 * MiB;
constexpr size_t WS_WUK = 183 * MiB, WS_WUV = 184 * MiB + 512 * 1024, WS_WUQ = 186 * MiB, WS_WBOUT = 189 * MiB;
constexpr size_t WS_HN = 197 * MiB;
constexpr size_t WS_ACT = 261 * MiB;
constexpr size_t WS_U = 261 * MiB, WS_VA = 309 * MiB, WS_MQ = 357 * MiB, WS_MIXA = 373 * MiB;
constexpr size_t WS_GOUT = 437 * MiB;
constexpr size_t WS_CKV = 261 * MiB, WS_ZQ = 277 * MiB, WS_KR = 293 * MiB, WS_MQB = 295 * MiB, WS_KN = 311 * MiB, WS_VT = 359 * MiB, WS_Q = 407 * MiB;
constexpr size_t WS_ST = 501 * MiB;
constexpr size_t WS_END = 504 * MiB;
constexpr int ST_VSUM = 0, ST_VSS = 16384 * 24;
constexpr int ST_G = 0;
constexpr int ST_CKV = 0, ST_CKVC = 16384 * 8, ST_Q = 2 * 16384 * 8;
constexpr int CTL_QUEUE = 0;
constexpr int CW_BAR = 1024;
constexpr size_t CTL_ZERO_BYTES = 65536;
constexpr size_t WS_HSS = 256 * 1024;

constexpr int LDS_BYTES = 147456;
constexpr int LDS_MISC = 131072;

struct Args { const float* in[24]; float* out; unsigned char* ws; int ph_lo, ph_hi; };

__device__ __forceinline__ float wave_sum(float v) {
#pragma unroll
    for (int o = 1; o < 64; o <<= 1) v += __shfl_xor(v, o);
    return v;
}
__device__ __forceinline__ unsigned pk2(float lo, float hi) { return pg8::cvt_pk_bf16(lo, hi); }
typedef float v2f_ __attribute__((ext_vector_type(2)));
typedef __bf16 v2bf_ __attribute__((ext_vector_type(2)));
__device__ __forceinline__ unsigned pk2b(float lo, float hi) { return __builtin_bit_cast(unsigned, __builtin_convertvector((v2f_){lo, hi}, v2bf_)); }
__device__ __forceinline__ float bf_lo(unsigned u) { return __uint_as_float(u << 16); }
__device__ __forceinline__ float bf_hi(unsigned u) { return __uint_as_float(u & 0xffff0000u); }
__device__ __forceinline__ void store8(bf16* p, v4f a, v4f b) { v4u w; w.x = pk2(a[0], a[1]); w.y = pk2(a[2], a[3]); w.z = pk2(b[0], b[1]); w.w = pk2(b[2], b[3]); *(v4u*)p = w; }
__device__ __forceinline__ float gelu_tanh(float x) {
    constexpr float K1 = -2.0f * LOG2E * 0.7978845608028654f, K2 = K1 * 0.044715f;
    const float y = x * __builtin_fmaf(K2, x * x, K1);
    return x * __builtin_amdgcn_rcpf(1.0f + __builtin_amdgcn_exp2f(y));
}
__device__ __forceinline__ float silu_mul(float g, float u) { return g * u * __builtin_amdgcn_rcpf(1.0f + __builtin_amdgcn_exp2f(-LOG2E * g)); }
__device__ __forceinline__ v4f gelu4(v4f v) { return (v4f){gelu_tanh(v[0]), gelu_tanh(v[1]), gelu_tanh(v[2]), gelu_tanh(v[3])}; }
__device__ __forceinline__ float sum4(v4f v) { return (v[0] + v[1]) + (v[2] + v[3]); }
__device__ __forceinline__ float ssq4(v4f v) { return (v[0] * v[0] + v[1] * v[1]) + (v[2] * v[2] + v[3] * v[3]); }

enum { EK_STORE = 0, EK_AIN = 1, EK_GATEUP = 2, EK_BIN = 3, EK_UQ = 4, EK_P9 = 5 };
constexpr int VT_CKV = (int)(WS_CKV >> 18), VT_WUK = (int)(WS_WUK >> 18), VT_WUV = (int)(WS_WUV >> 18), VT_ZQ = (int)(WS_ZQ >> 18), VT_WUQ = (int)(WS_WUQ >> 18);
static_assert((WS_CKV & 262143) == 0 && (WS_WUK & 262143) == 0 && (WS_WUV & 262143) == 0 && (WS_ZQ & 262143) == 0 && (WS_WUQ & 262143) == 0, "phase-9 operands sit on 256-KiB tile boundaries");
struct Epi {
    static constexpr bool PERM = true, AFTER_DRAIN = false;
    int kind, scale_mode  , accss, ldc;
    bf16* o0; const float* ssin; float inv_n; float* ss0; int nslots; int vt_nt; unsigned char* wsb;
    int pm_cached; LAS const float* lrs;
    __device__ __forceinline__ void operator()(const pg8::f32x4 (&acc)[2][2][4][2], const pg8::Unit& u, int wr_, int wc_, int fr_, int fq_) const {
        int tid_ = threadIdx.x; asm volatile("" : "+v"(tid_));
        const int wr = tid_ >> 8, wc = (tid_ >> 6) & 3, fr = tid_ & 15, fq = (tid_ >> 4) & 3;
        int kind_ = kind, scale_ = scale_mode, ldc_ = ldc, pm_ = __builtin_amdgcn_readfirstlane(u.pm), pn = __builtin_amdgcn_readfirstlane(u.pn);
        bf16* o0_ = o0; const float* ssin_ = ssin;
        if (kind == EK_P9) {
            if (pn >= VT_WUK && pn < VT_WUK + 6) { kind_ = EK_STORE; scale_ = 1; ldc_ = 1536; pn -= VT_WUK; pm_ -= VT_CKV; o0_ = (bf16*)(wsb + WS_KN); ssin_ = (const float*)(wsb + WS_ST) + ST_CKV; }
            else if (pn >= VT_WUQ && pn < VT_WUQ + 9) { kind_ = EK_UQ; pn -= VT_WUQ; pm_ -= VT_ZQ; o0_ = (bf16*)(wsb + WS_Q); ssin_ = (const float*)(wsb + WS_ST) + ST_Q; }
            else { kind_ = EK_STORE; scale_ = 2; ldc_ = NTOK; pn -= VT_CKV; pm_ -= VT_WUV; o0_ = (bf16*)(wsb + WS_VT); ssin_ = (const float*)(wsb + WS_ST) + ST_CKVC; }
        }
        const int row0 = pm_ * 256 + wr * 64 + fr;
        const int cl = wc * 32 + 8 * fq;
        if (kind_ == EK_STORE) {
            const int col0 = pn * 256 + cl;
            if (scale_ == 2) {
                v4f cs[2][2];
#pragma unroll
                for (int bj = 0; bj < 2; ++bj)
#pragma unroll
                    for (int n = 0; n < 2; ++n) { v4f t = *(const v4f*)(ssin_ + col0 + bj * 128 + 4 * n);
#pragma unroll
                        for (int sl = 1; sl < 8; ++sl) t += *(const v4f*)(ssin_ + sl * 16384 + col0 + bj * 128 + 4 * n);
                        cs[bj][n] = (v4f){__builtin_amdgcn_rsqf(t[0] * inv_n + EPS), __builtin_amdgcn_rsqf(t[1] * inv_n + EPS), __builtin_amdgcn_rsqf(t[2] * inv_n + EPS), __builtin_amdgcn_rsqf(t[3] * inv_n + EPS)}; }
#pragma unroll
                for (int ai = 0; ai < 2; ++ai)
#pragma unroll
                    for (int m = 0; m < 4; ++m) {
                        const int row = row0 + ai * 128 + m * 16;
#pragma unroll
                        for (int bj = 0; bj < 2; ++bj) { const int tk = col0 + bj * 128;
                            store8(o0_ + (unsigned)((((row >> 7) * 256 + (tk >> 6)) * 128 + (row & 127)) * 64 + (tk & 63)), acc[ai][bj][m][0] * cs[bj][0], acc[ai][bj][m][1] * cs[bj][1]); }
                    }
            } else {
                float rsv8[8];
#pragma unroll
                for (int i = 0; i < 8; ++i) { rsv8[i] = 1.f; if (scale_ == 1) { const int row = row0 + (i >> 2) * 128 + (i & 3) * 16; const v4f t0 = *(const v4f*)(ssin_ + (unsigned)(row * 8)), t1 = *(const v4f*)(ssin_ + (unsigned)(row * 8) + 4); rsv8[i] = __builtin_amdgcn_rsqf((sum4(t0) + sum4(t1)) * inv_n + EPS); } }
#pragma unroll
                for (int ai = 0; ai < 2; ++ai)
#pragma unroll
                    for (int m = 0; m < 4; ++m) {
                        const int row = row0 + ai * 128 + m * 16;
                        const float rs = rsv8[ai * 4 + m];
                        float q = 0.f;
#pragma unroll
                        for (int bj = 0; bj < 2; ++bj) {
                            const v4f v0 = acc[ai][bj][m][0] * rs, v1 = acc[ai][bj][m][1] * rs;
                            q += ssq4(v0) + ssq4(v1);
                            const int tk = col0 + bj * 128;
                            const unsigned off = vt_nt ? (unsigned)((((row >> 7) * vt_nt + (tk >> 6)) * 128 + (row & 127)) * 64 + (tk & 63)) : (unsigned)(row * ldc_ + tk);
                            store8(o0_ + off, v0, v1);
                        }
                        if (accss) { q += __shfl_xor(q, 16); q += __shfl_xor(q, 32); if (fq == 0) ss0[(unsigned)(row * nslots + pn * 4 + wc)] = q; }
                    }
            }
        } else if (kind_ == EK_AIN) {
            const int k3 = pn < 6 ? 0 : (pn < 12 ? 1 : 2);
            bf16* base = (bf16*)(wsb + (k3 == 0 ? WS_U : (k3 == 1 ? WS_VA : WS_MQ)));
            const int ld = k3 == 2 ? 512 : 1536;
            float* const ss0 = (float*)(wsb + WS_ST) + ST_VSUM; float* const ss1 = (float*)(wsb + WS_ST) + ST_VSS;
            const int col0 = (k3 == 0 ? pn : (k3 == 1 ? pn - 6 : pn - 12)) * 256 + cl;
#pragma unroll
            for (int ai = 0; ai < 2; ++ai)
#pragma unroll
                for (int m = 0; m < 4; ++m) {
                    const int row = row0 + ai * 128 + m * 16;
                    float s1 = 0.f, s2 = 0.f;
#pragma unroll
                    for (int bj = 0; bj < 2; ++bj) {
                        v4f v0 = acc[ai][bj][m][0], v1 = acc[ai][bj][m][1];
                        if (k3 < 2) { v0 = gelu4(v0); v1 = gelu4(v1); } else { v0 = v0 * QSCALE_MEM; v1 = v1 * QSCALE_MEM; }
                        s1 += sum4(v0) + sum4(v1); s2 += ssq4(v0) + ssq4(v1);
                        store8(base + (unsigned)(row * ld + col0) + bj * 128, v0, v1);
                    }
                    if (k3 == 1) { s1 += __shfl_xor(s1, 16); s1 += __shfl_xor(s1, 32); s2 += __shfl_xor(s2, 16); s2 += __shfl_xor(s2, 32);
                        if (fq == 0) { const unsigned si = (unsigned)(row * 24 + (pn - 6) * 4 + wc); ss0[si] = s1; ss1[si] = s2; } }
                }
        } else if (kind_ == EK_GATEUP) {
            const int col0 = pn * 128 + cl;
            float rsv[8];
            if (__builtin_amdgcn_readfirstlane(u.pm) == pm_cached) {
                const v4f r0 = *(LAS const v4f*)(lrs + (wr * 16 + fr) * 8), r1 = *(LAS const v4f*)(lrs + (wr * 16 + fr) * 8 + 4);
#pragma unroll
                for (int i = 0; i < 4; ++i) { rsv[i] = r0[i]; rsv[4 + i] = r1[i]; }
            } else { const float* hp = (const float*)(wsb + WS_HSS) + u.pm * 256 + (wr * 16 + fr) * 8; const v4f r0 = *(const v4f*)hp, r1 = *(const v4f*)(hp + 4);
#pragma unroll
              for (int i = 0; i < 4; ++i) { rsv[i] = __builtin_amdgcn_rsqf(r0[i] * (1.f / DM) + EPS); rsv[4 + i] = __builtin_amdgcn_rsqf(r1[i] * (1.f / DM) + EPS); } }
#pragma unroll
            for (int ai = 0; ai < 2; ++ai)
#pragma unroll
                for (int m = 0; m < 4; ++m) {
                    const int row = row0 + ai * 128 + m * 16;
                    const float rs = rsv[ai * 4 + m];
                    const float c1 = -LOG2E * rs, rs2 = rs * rs;
                    v4f a0, a1;
#pragma unroll
                    for (int e = 0; e < 4; ++e) {
                        const float g0_ = acc[ai][0][m][0][e], g1_ = acc[ai][0][m][1][e];
                        a0[e] = (g0_ * acc[ai][1][m][0][e]) * (rs2 * __builtin_amdgcn_rcpf(1.0f + __builtin_amdgcn_exp2f(g0_ * c1)));
                        a1[e] = (g1_ * acc[ai][1][m][1][e]) * (rs2 * __builtin_amdgcn_rcpf(1.0f + __builtin_amdgcn_exp2f(g1_ * c1))); }
                    store8(o0 + (unsigned)(row * DFF + col0), a0, a1);
                }
        } else if (kind_ == EK_BIN) {
            const float* const cosT = (const float*)(wsb + WS_COS); const float* const sinT = (const float*)(wsb + WS_SIN); bf16* const o2 = (bf16*)(wsb + WS_KR);
            float rsv[8];
            if (__builtin_amdgcn_readfirstlane(u.pm) == pm_cached) {
                const v4f r0 = *(LAS const v4f*)(lrs + (wr * 16 + fr) * 8), r1 = *(LAS const v4f*)(lrs + (wr * 16 + fr) * 8 + 4);
#pragma unroll
                for (int i = 0; i < 4; ++i) { rsv[i] = r0[i]; rsv[4 + i] = r1[i]; }
            } else { const float* hp = (const float*)(wsb + WS_HSS) + u.pm * 256 + (wr * 16 + fr) * 8; const v4f r0 = *(const v4f*)hp, r1 = *(const v4f*)(hp + 4);
#pragma unroll
              for (int i = 0; i < 4; ++i) { rsv[i] = __builtin_amdgcn_rsqf(r0[i] * (1.f / DM) + EPS); rsv[4 + i] = __builtin_amdgcn_rsqf(r1[i] * (1.f / DM) + EPS); } }
            if (pn == 2) {
                if (wc == 0) {
#pragma unroll
                    for (int ai = 0; ai < 2; ++ai)
#pragma unroll
                        for (int m = 0; m < 4; ++m) {
                            const int row = row0 + ai * 128 + m * 16;
                            const float rs = rsv[ai * 4 + m];
                            v4f y1[2], y2[2];
#pragma unroll
                            for (int n = 0; n < 2; ++n) { const v4f c = *(const v4f*)(cosT + (unsigned)(row * 32) + 8 * fq + 4 * n), s = *(const v4f*)(sinT + (unsigned)(row * 32) + 8 * fq + 4 * n);
                                const v4f x1 = acc[ai][0][m][n] * rs, x2 = acc[ai][1][m][n] * rs; y1[n] = x1 * c - x2 * s; y2[n] = x2 * c + x1 * s; }
                            store8(o2 + (unsigned)(row * 64) + 8 * fq, y1[0], y1[1]);
                            store8(o2 + (unsigned)(row * 64) + 32 + 8 * fq, y2[0], y2[1]);
                        }
                }
            } else {
                const int k3 = pn < 2 ? 0 : (pn < 5 ? 1 : 2);
                bf16* base = (bf16*)(wsb + (k3 == 0 ? WS_CKV : (k3 == 1 ? WS_ZQ : WS_MQB)));
                float* ssp = (float*)(wsb + WS_ST) + (k3 == 0 ? ST_CKV : ST_Q); float* const ssc = (float*)(wsb + WS_ST) + ST_CKVC;
                const int col0 = (k3 == 0 ? pn : (k3 == 1 ? pn - 3 : pn - 5)) * 256 + cl;
#pragma unroll
                for (int ai = 0; ai < 2; ++ai)
#pragma unroll
                    for (int m = 0; m < 4; ++m) {
                        const int row = row0 + ai * 128 + m * 16;
                        const float rs = rsv[ai * 4 + m] * (k3 == 2 ? QSCALE_MEM : 1.f);
                        float q = 0.f;
#pragma unroll
                        for (int bj = 0; bj < 2; ++bj) {
                            const v4f v0 = acc[ai][bj][m][0] * rs, v1 = acc[ai][bj][m][1] * rs;
                            q += ssq4(v0) + ssq4(v1);
                            store8(base + (unsigned)(row * 512 + col0) + bj * 128, v0, v1);
                        }
                        if (k3 < 2) { q += __shfl_xor(q, 16); q += __shfl_xor(q, 32); const int sl = (k3 == 0 ? pn : pn - 3) * 4 + wc;
                            if (fq == 0) { ssp[(unsigned)(row * 8 + sl)] = q; if (k3 == 0) ssc[(unsigned)(sl * 16384 + row)] = q; } }
                    }
            }
        } else {
            const float* const cosT = (const float*)(wsb + WS_COS); const float* const sinT = (const float*)(wsb + WS_SIN);
            float rsv8[8];
#pragma unroll
            for (int i = 0; i < 8; ++i) { const int row = row0 + (i >> 2) * 128 + (i & 3) * 16; const v4f t0 = *(const v4f*)(ssin_ + (unsigned)(row * 8)), t1 = *(const v4f*)(ssin_ + (unsigned)(row * 8) + 4);
                rsv8[i] = __builtin_amdgcn_rsqf((sum4(t0) + sum4(t1)) * inv_n + EPS) * QSCALE_MLA; }
            if (pn < 6) {
#pragma unroll
                for (int ai = 0; ai < 2; ++ai)
#pragma unroll
                    for (int m = 0; m < 4; ++m) {
                        const int row = row0 + ai * 128 + m * 16; const float rs = rsv8[ai * 4 + m];
                        bf16* qrow = o0_ + (unsigned)(row * 2304);
#pragma unroll
                        for (int bj = 0; bj < 2; ++bj) store8(qrow + (pn * 2 + bj) * 192 + cl, acc[ai][bj][m][0] * rs, acc[ai][bj][m][1] * rs);
                    }
            } else {
                const int head = 4 * (pn - 6) + wc;
#pragma unroll
                for (int h2 = 0; h2 < 4; ++h2) {
                    const int ai = h2 >> 1, mb = (h2 & 1) * 2;
                    v4f cc[2][2], sn[2][2];
#pragma unroll
                    for (int mm = 0; mm < 2; ++mm)
#pragma unroll
                        for (int n = 0; n < 2; ++n) { const int row = row0 + ai * 128 + (mb + mm) * 16; cc[mm][n] = *(const v4f*)(cosT + (unsigned)(row * 32) + 8 * fq + 4 * n); sn[mm][n] = *(const v4f*)(sinT + (unsigned)(row * 32) + 8 * fq + 4 * n); }
#pragma unroll
                    for (int mm = 0; mm < 2; ++mm) {
                        const int m = mb + mm;
                        const int row = row0 + ai * 128 + m * 16; const float rs = rsv8[ai * 4 + m];
                        bf16* qrow = o0_ + (unsigned)(row * 2304);
                        v4f y1[2], y2[2];
#pragma unroll
                        for (int n = 0; n < 2; ++n) { const v4f x1 = acc[ai][0][m][n] * rs, x2 = acc[ai][1][m][n] * rs; y1[n] = x1 * cc[mm][n] - x2 * sn[mm][n]; y2[n] = x2 * cc[mm][n] + x1 * sn[mm][n]; }
                        store8(qrow + head * 192 + 128 + 8 * fq, y1[0], y1[1]);
                        store8(qrow + head * 192 + 160 + 8 * fq, y2[0], y2[1]);
                    }
                }
            }
        }
    }
};

__device__ __forceinline__ void tr_load(float (&v)[32], const float* W, int ldw, int k0, int n0, int lane) {
    const float* src = W + (size_t)(k0 + (lane >> 5)) * ldw + n0 + (lane & 31);
#pragma unroll
    for (int i = 0; i < 32; ++i) v[i] = src[(size_t)(2 * i) * ldw];
}
__device__ __forceinline__ void tr_store(const float (&v)[32], int k0, const float* gain, bf16* dst, int K, LAS float* scr, int lane) {
    const int c = lane & 7;
    v4f g0 = (v4f){1.f, 1.f, 1.f, 1.f}, g1 = g0;
    if (gain) { g0 = *(const v4f*)(gain + k0 + 8 * c); g1 = *(const v4f*)(gain + k0 + 8 * c + 4); }
#pragma unroll
    for (int i = 0; i < 32; ++i) scr[(2 * i + (lane >> 5)) * 33 + (lane & 31)] = v[i];
    asm volatile("s_waitcnt lgkmcnt(0)" ::: "memory");
#pragma unroll
    for (int j = 0; j < 4; ++j) { const int n = (lane >> 3) + 8 * j; const LAS float* s = scr + (8 * c) * 33 + n;
        v4u o; o.x = pk2(s[0 * 33] * g0[0], s[1 * 33] * g0[1]); o.y = pk2(s[2 * 33] * g0[2], s[3 * 33] * g0[3]); o.z = pk2(s[4 * 33] * g1[0], s[5 * 33] * g1[1]); o.w = pk2(s[6 * 33] * g1[2], s[7 * 33] * g1[3]);
        *(v4u*)(dst + (size_t)n * K + k0 + 8 * c) = o; }
    asm volatile("s_waitcnt lgkmcnt(0)" ::: "memory");
}
constexpr int I_AIN = 32 * 112, I_MKV = 32 * 32, I_SQ = 32 * 64, I_GU = 32 * 176, I_DN = 88 * 64, I_KVA = 32 * 18, I_BIN = 32 * 32, I_UK = 8 * 48, I_UQ = 8 * 72;
constexpr int NITEMS = I_AIN + 2 * I_MKV + I_SQ + 4 * I_GU + 2 * I_DN + I_KVA + I_BIN + 2 * I_UK + I_UQ + I_SQ;
__device__ __forceinline__ void tr_decode(const Args& a, int it, const float*& W, int& ldw, int& k0, int& n0, const float*& gain, bf16*& dst, int& K) {
    unsigned char* ws = a.ws; const float* ng = a.in[3]; int r = it;
    if (r < I_AIN) { const int kb = r / 112, nb = r % 112; W = a.in[9]; ldw = 3584; k0 = 64 * kb; n0 = 32 * nb; gain = ng; dst = (bf16*)(ws + WS_WAIN) + (size_t)(32 * nb) * 2048; K = 2048; return; } r -= I_AIN;
    if (r < 2 * I_MKV) { const int l = r / I_MKV; r %= I_MKV; const int kb = r / 32, nb = r % 32; n0 = 32 * nb;
        dst = n0 < 512 ? (bf16*)(ws + WS_WMK) + (size_t)(l * 512 + n0) * 2048 : (bf16*)(ws + WS_WMV) + (size_t)(l * 512 + n0 - 512) * 2048;
        W = a.in[5] + (size_t)l * 2048 * 1024; ldw = 1024; k0 = 64 * kb; gain = a.in[4] + l * 2048; K = 2048; return; } r -= 2 * I_MKV;
    if (r < I_SQ) { const int kb = r / 64, nb = r % 64; W = a.in[14]; ldw = 2048; k0 = 64 * kb; n0 = 32 * nb; gain = nullptr; dst = (bf16*)(ws + WS_WAOUT) + (size_t)(32 * nb) * 2048; K = 2048; return; } r -= I_SQ;
    if (r < 4 * I_GU) { const int q = r / I_GU; r %= I_GU; const int l = q >> 1, isup = q & 1; const int kb = r / 176, nb = r % 176; n0 = 32 * nb;
        W = (isup ? a.in[7] : a.in[6]) + (size_t)l * 2048 * DFF; ldw = DFF; k0 = 64 * kb; gain = ng + (l * 4 + 2) * 2048; K = 2048;
        dst = (bf16*)(ws + (l ? WS_WGU1 : WS_WGU0)) + (size_t)(256 * (n0 / 128) + 128 * isup + (n0 % 128)) * 2048; return; } r -= 4 * I_GU;
    if (r < 2 * I_DN) { const int l = r / I_DN; r %= I_DN; const int kb = r / 64, nb = r % 64;
        W = a.in[8] + (size_t)l * DFF * 2048; ldw = 2048; k0 = 64 * kb; n0 = 32 * nb; gain = nullptr; dst = (bf16*)(ws + (l ? WS_WDN1 : WS_WDN0)) + (size_t)(32 * nb) * DFF; K = DFF; return; } r -= 2 * I_DN;
    if (r < I_KVA) { const int kb = r / 18, nb = r % 18; n0 = 32 * nb; const int drow = n0 < 512 ? n0 : (n0 == 512 ? 512 : 640);
        W = a.in[16]; ldw = 576; k0 = 64 * kb; gain = a.in[15]; dst = (bf16*)(ws + WS_WBIN) + (size_t)drow * 2048; K = 2048; return; } r -= I_KVA;
    if (r < I_BIN) { const int kb = r / 32, nb = r % 32; W = a.in[20]; ldw = 1024; k0 = 64 * kb; n0 = 32 * nb; gain = ng + 4 * 2048; dst = (bf16*)(ws + WS_WBIN) + (size_t)(768 + 32 * nb) * 2048; K = 2048; return; } r -= I_BIN;
    if (r < 2 * I_UK) { const int isv = r / I_UK; r %= I_UK; const int kb = r / 48, nb = r % 48;
        W = isv ? a.in[19] : a.in[18]; ldw = 1536; k0 = 64 * kb; n0 = 32 * nb; gain = a.in[17]; dst = (bf16*)(ws + (isv ? WS_WUV : WS_WUK)) + (size_t)(32 * nb) * 512; K = 512; return; } r -= 2 * I_UK;
    if (r < I_UQ) { const int kb = r / 72, nb = r % 72; n0 = 32 * nb; const int h = n0 / 192, d0 = n0 % 192;
        const int drow = d0 < 128 ? h * 128 + d0 : 1536 + 256 * (h >> 2) + 128 * ((d0 - 128) >> 5) + 32 * (h & 3);
        W = a.in[22]; ldw = 2304; k0 = 64 * kb; gain = a.in[21]; dst = (bf16*)(ws + WS_WUQ) + (size_t)drow * 512; K = 512; return; } r -= I_UQ;
    { const int kb = r / 64, nb = r % 64; W = a.in[23]; ldw = 2048; k0 = 64 * kb; n0 = 32 * nb; gain = nullptr; dst = (bf16*)(ws + WS_WBOUT) + (size_t)(32 * nb) * 2048; K = 2048; }
}
__device__ __forceinline__ void rms_row_bf16(const float* xrow, bf16* orow, int lane) {
    v4f v[8]; float s = 0.f;
#pragma unroll
    for (int j = 0; j < 4; ++j) { v[2 * j] = *(const v4f*)(xrow + 8 * (lane + 64 * j)); v[2 * j + 1] = *(const v4f*)(xrow + 8 * (lane + 64 * j) + 4); s += ssq4(v[2 * j]) + ssq4(v[2 * j + 1]); }
    const float rstd = __builtin_amdgcn_rsqf(wave_sum(s) * (1.f / DM) + EPS);
#pragma unroll
    for (int j = 0; j < 4; ++j) store8(orow + 8 * (lane + 64 * j), v[2 * j] * rstd, v[2 * j + 1] * rstd);
}

__device__ __forceinline__ void prologue(const Args& a, LAS unsigned char* lds) {
    int tid = threadIdx.x; asm volatile("" : "+v"(tid));
    const int lane = tid & 63, wave = __builtin_amdgcn_readfirstlane(tid >> 6);
    int G = gridDim.x; asm volatile("" : "+s"(G));
    const int gw = blockIdx.x * 8 + wave, NGW = G * 8, gt = blockIdx.x * 512 + tid, NGT = G * 512;
    unsigned char* ws = a.ws;
    for (int i = gt; i < 2 * 96 * 1024; i += NGT) { const int blk = i / (96 * 1024), r = i % (96 * 1024); ((unsigned*)(ws + WS_WBIN))[(size_t)(blk == 0 ? 544 : 672) * 1024 + r] = 0u; }
    { const float* wsrc = a.in[12]; bf16* wd = (bf16*)(ws + WS_WS);
      for (int i = gt; i < 12 * 128 * 128; i += NGT) { const int t = (i >> 7) & 127, s = i & 127; wd[i] = (bf16)(pk2(s <= t ? wsrc[i] : 0.f, 0.f) & 0xffffu); } }
    { const int* pos = (const int*)a.in[2]; float* ct = (float*)(ws + WS_COS); float* st = (float*)(ws + WS_SIN);
      for (int i = gt; i < NTOK * 32; i += NGT) { const int tok = i >> 5, k = i & 31;
          const double invf = (double)__builtin_amdgcn_exp2f(-(float)(2 * k) * (13.287712379549449f / 64.f));
          const double rev = (double)pos[tok] * invf * 0.15915494309189535; const float fr = (float)(rev - __builtin_floor(rev));
          ct[i] = __builtin_amdgcn_cosf(fr); st[i] = __builtin_amdgcn_sinf(fr); } }
    LAS float* scr = (LAS float*)(lds + wave * 16384);
    {
        float va[32], vb[32];
        const float *Wa, *Wb, *ga, *gb; int lda, ldb_, k0a, k0b, n0a, n0b, Ka, Kb2; bf16 *da, *db;
        int it = gw;
        if (it < NITEMS) { tr_decode(a, it, Wa, lda, k0a, n0a, ga, da, Ka); tr_load(va, Wa, lda, k0a, n0a, lane); }
        for (; it < NITEMS; it += 2 * NGW) {
            const int i2 = it + NGW; const bool h2 = i2 < NITEMS;
            if (h2) { tr_decode(a, i2, Wb, ldb_, k0b, n0b, gb, db, Kb2); tr_load(vb, Wb, ldb_, k0b, n0b, lane); }
            tr_store(va, k0a, ga, da, Ka, scr, lane);
            const int i3 = i2 + NGW;
            if (i3 < NITEMS) { tr_decode(a, i3, Wa, lda, k0a, n0a, ga, da, Ka); tr_load(va, Wa, lda, k0a, n0a, lane); }
            if (h2) tr_store(vb, k0b, gb, db, Kb2, scr, lane);
        }
    }
    for (int m = gw; m < NTOK; m += NGW) rms_row_bf16(a.in[0] + (size_t)m * DM, (bf16*)(ws + WS_HN) + (size_t)m * DM, lane);
    for (int m = gw; m < 1024; m += NGW) rms_row_bf16(a.in[1] + (size_t)m * DM, (bf16*)(ws + WS_MEMN) + (size_t)m * DM, lane);
}

__device__ __forceinline__ void rowpass(const float* hin32, bf16* hbf, const bf16* gout, const float* ss, const float* gain, float* hss, float* out32) {
    int tid_ = threadIdx.x; asm volatile("" : "+v"(tid_));
    const int lane = tid_ & 63, wave = __builtin_amdgcn_readfirstlane(tid_ >> 6), gw = blockIdx.x * 8 + wave, NGW = gridDim.x * 8;
    for (int m0 = gw; m0 < NTOK; m0 += 2 * NGW) {
        const int m1 = (m0 + NGW < NTOK) ? m0 + NGW : m0;
        float sp[2]; v4u g[2][4]; v4u hb16[2][4]; v4f hf[2][8];
#pragma unroll
        for (int r = 0; r < 2; ++r) { const int m = r ? m1 : m0;
            sp[r] = lane < 32 ? ss[(size_t)m * 32 + lane] : 0.f;
#pragma unroll
            for (int j = 0; j < 4; ++j) { const int c = 8 * (lane + 64 * j);
                g[r][j] = *(const v4u*)(gout + (size_t)m * DM + c);
                if (hin32) { hf[r][2 * j] = *(const v4f*)(hin32 + (size_t)m * DM + c); hf[r][2 * j + 1] = *(const v4f*)(hin32 + (size_t)m * DM + c + 4); }
                else hb16[r][j] = *(const v4u*)(hbf + (size_t)m * DM + c); } }
#pragma unroll
        for (int r = 0; r < 2; ++r) { const int m = r ? m1 : m0;
            const float rs = __builtin_amdgcn_rsqf(wave_sum(sp[r]) * (1.f / DM) + EPS);
            float s = 0.f;
#pragma unroll
            for (int j = 0; j < 4; ++j) { const int c = 8 * (lane + 64 * j);
                v4f h0, h1;
                if (hin32) { h0 = hf[r][2 * j]; h1 = hf[r][2 * j + 1]; }
                else { const v4u hv = hb16[r][j]; h0 = (v4f){bf_lo(hv.x), bf_hi(hv.x), bf_lo(hv.y), bf_hi(hv.y)}; h1 = (v4f){bf_lo(hv.z), bf_hi(hv.z), bf_lo(hv.w), bf_hi(hv.w)}; }
                const v4f g0 = *(const v4f*)(gain + c), g1 = *(const v4f*)(gain + c + 4);
                const v4u gg = g[r][j];
                const v4f a0 = (v4f){bf_lo(gg.x), bf_hi(gg.x), bf_lo(gg.y), bf_hi(gg.y)}, a1 = (v4f){bf_lo(gg.z), bf_hi(gg.z), bf_lo(gg.w), bf_hi(gg.w)};
                const v4f v0 = h0 + a0 * rs * g0, v1 = h1 + a1 * rs * g1;
                if (out32) { *(v4f*)(out32 + (size_t)m * DM + c) = v0; *(v4f*)(out32 + (size_t)m * DM + c + 4) = v1; }
                else { store8(hbf + (size_t)m * DM + c, v0, v1); s += ssq4(v0) + ssq4(v1); } }
            if (!out32) { const float t = wave_sum(s); const int rr = m & 255; if (lane == 0) hss[(m & ~255) + (((rr >> 6) & 1) * 16 + (rr & 15)) * 8 + (rr >> 7) * 4 + ((rr >> 4) & 3)] = t; } }
    }
}

__device__ __forceinline__ void gating_phase(const Args& a, LAS unsigned char* lds) {
    int tid = threadIdx.x; asm volatile("" : "+v"(tid));
    const int lane = tid & 63, w = __builtin_amdgcn_readfirstlane(tid >> 6);
    unsigned char* ws = a.ws;
    const bf16* U = (const bf16*)(ws + WS_U); const bf16* VA = (const bf16*)(ws + WS_VA); bf16* MIX = (bf16*)(ws + WS_MIXA);
    const bf16* WS_ = (const bf16*)(ws + WS_WS);
    const float* vsum = (const float*)(ws + WS_ST) + ST_VSUM; const float* vss = (const float*)(ws + WS_ST) + ST_VSS;
    LAS float* lst = (LAS float*)(lds + 36864);
    const float* lng = a.in[10]; const float* lnb = a.in[11]; const float* bs = a.in[13];
    constexpr int VP = 136;
    LAS bf16* vT = (LAS bf16*)lds;
    for (int unit = blockIdx.x; unit < 128 * 12; unit += gridDim.x) {
        const int n = unit / 12, g = unit % 12, T0 = 128 * n;
        if (tid < 128) { const float* p1 = vsum + (size_t)(T0 + tid) * 24; const float* p2 = vss + (size_t)(T0 + tid) * 24; float a1 = 0.f, a2 = 0.f;
#pragma unroll
            for (int k = 0; k < 6; ++k) { a1 += sum4(*(const v4f*)(p1 + 4 * k)); a2 += sum4(*(const v4f*)(p2 + 4 * k)); }
            const float mean = a1 * (1.f / TOKW), var = a2 * (1.f / TOKW) - mean * mean; lst[2 * tid] = mean; lst[2 * tid + 1] = __builtin_amdgcn_rsqf(var + EPS); }
        __syncthreads();
        const int t = 16 * w + (lane & 15), kq = lane >> 4;
        const bf16* wrow = WS_ + ((size_t)g * 128 + t) * 128 + 8 * kq;
        v8s wf[4];
#pragma unroll
        for (int ks = 0; ks < 4; ++ks) wf[ks] = *(const v8s*)(wrow + 32 * ks);
        const float bias = bs[g * 128 + t];
        const int nks = (w >> 1) + 1;
#pragma unroll
        for (int i = 0; i < 4; ++i) {
            const int c = tid + 512 * i, s = c >> 4, c8 = c & 15;
            const v4u raw = *(const v4u*)(VA + (size_t)(T0 + s) * TOKW + g * 128 + c8 * 8);
            const float mean = lst[2 * s], rstd = lst[2 * s + 1];
            const v4f g0 = *(const v4f*)(lng + g * 128 + c8 * 8), g1 = *(const v4f*)(lng + g * 128 + c8 * 8 + 4), b0 = *(const v4f*)(lnb + g * 128 + c8 * 8), b1 = *(const v4f*)(lnb + g * 128 + c8 * 8 + 4);
            const v4f x0 = (v4f){bf_lo(raw.x), bf_hi(raw.x), bf_lo(raw.y), bf_hi(raw.y)}, x1 = (v4f){bf_lo(raw.z), bf_hi(raw.z), bf_lo(raw.w), bf_hi(raw.w)};
            const v4f y0 = (x0 - mean) * rstd * g0 + b0, y1 = (x1 - mean) * rstd * g1 + b1;
            const unsigned p0 = pk2(y0[0], y0[1]), p1 = pk2(y0[2], y0[3]), p2 = pk2(y1[0], y1[1]), p3 = pk2(y1[2], y1[3]);
            LAS bf16* d = vT + (c8 * 8) * VP + s;
            d[0 * VP] = (bf16)(p0 & 0xffffu); d[1 * VP] = (bf16)(p0 >> 16); d[2 * VP] = (bf16)(p1 & 0xffffu); d[3 * VP] = (bf16)(p1 >> 16);
            d[4 * VP] = (bf16)(p2 & 0xffffu); d[5 * VP] = (bf16)(p2 >> 16); d[6 * VP] = (bf16)(p3 & 0xffffu); d[7 * VP] = (bf16)(p3 >> 16);
        }
        __syncthreads();
#pragma unroll
        for (int ibp = 0; ibp < 4; ++ibp) {
            const int ib0 = 2 * ibp;
            v4f acc0 = (v4f){0.f, 0.f, 0.f, 0.f}, acc1 = acc0;
#pragma unroll
            for (int ks = 0; ks < 4; ++ks) if (ks < nks) {
                const v8s af0 = *(const LAS v8s*)(vT + (16 * ib0 + (lane & 15)) * VP + 32 * ks + 8 * kq);
                const v8s af1 = *(const LAS v8s*)(vT + (16 * ib0 + 16 + (lane & 15)) * VP + 32 * ks + 8 * kq);
                acc0 = __builtin_amdgcn_mfma_f32_16x16x32_bf16(af0, wf[ks], acc0, 0, 0, 0);
                acc1 = __builtin_amdgcn_mfma_f32_16x16x32_bf16(af1, wf[ks], acc1, 0, 0, 0);
            }
            const size_t tok = (size_t)(T0 + t);
            const int cpos = g * 128 + 16 * (ib0 + (kq & 1)) + 4 * (kq & 2);
            const v4u ul = *(const v4u*)(U + tok * TOKW + cpos);
            unsigned ax = ul.x, ay = ul.y, bx = ul.z, by = ul.w;
            { const auto rx = __builtin_amdgcn_permlane16_swap(ax, bx, false, false); ax = rx[0]; bx = rx[1];
              const auto ry = __builtin_amdgcn_permlane16_swap(ay, by, false, false); ay = ry[0]; by = ry[1]; }
            unsigned ox0 = pk2b(bf_lo(ax) * (acc0[0] + bias), bf_hi(ax) * (acc0[1] + bias)), oy0 = pk2b(bf_lo(ay) * (acc0[2] + bias), bf_hi(ay) * (acc0[3] + bias));
            unsigned ox1 = pk2b(bf_lo(bx) * (acc1[0] + bias), bf_hi(bx) * (acc1[1] + bias)), oy1 = pk2b(bf_lo(by) * (acc1[2] + bias), bf_hi(by) * (acc1[3] + bias));
            { const auto rx = __builtin_amdgcn_permlane16_swap(ox0, ox1, false, false); ox0 = rx[0]; ox1 = rx[1];
              const auto ry = __builtin_amdgcn_permlane16_swap(oy0, oy1, false, false); oy0 = ry[0]; oy1 = ry[1]; }
            v4u ov; ov.x = ox0; ov.y = oy0; ov.z = ox1; ov.w = oy1;
            *(v4u*)(MIX + tok * DM + cpos) = ov;
        }
        __syncthreads();
    }
}

template <int DQK, bool CAUSAL>
__device__ __forceinline__ void attn_unit(LAS unsigned char* lds, const bf16* Qp, int qpitch, const bf16* Kp, int kpitch, const bf16* KRp,
                                          const bf16* VTp  , bf16* Op, int opitch, int ntiles, int q0) {
    constexpr int KP = DQK + 8, VP = 72, KBYTES = 64 * KP * 2, VBYTES = 128 * VP * 2, NS = DQK / 16;
    int tid = threadIdx.x; asm volatile("" : "+v"(tid));
    const int lane = tid & 63, w = __builtin_amdgcn_readfirstlane(tid >> 6), r = lane & 31, hh = lane >> 5;
    LAS unsigned char* Kb = lds; LAS unsigned char* Vb = lds + 2 * KBYTES;
    v8s qf[NS];
    { const bf16* qrow = Qp + (size_t)(32 * w + r) * qpitch + 8 * hh;
#pragma unroll
      for (int s = 0; s < NS; ++s) qf[s] = *(const v8s*)(qrow + 16 * s); }
    v16f o[4];
#pragma unroll
    for (int i = 0; i < 4; ++i)
#pragma unroll
        for (int j = 0; j < 16; ++j) o[i][j] = 0.f;
    float m_ref = 0.f, l_run = 0.f;
    v4u kreg[3], vreg[2];
    const int kkey = tid >> 4, kc8 = tid & 15;
    const int rkey = tid >> 3, rc8 = tid & 7;
    const int vdv = tid >> 3, vkc = tid & 7;
#define ATT_LOAD(t) do { \
        _Pragma("unroll") for (int i = 0; i < 2; ++i) kreg[i] = *(const v4u*)(Kp + (size_t)((t) * 64 + kkey + 32 * i) * kpitch + kc8 * 8); \
        if (DQK == 192) kreg[2] = *(const v4u*)(KRp + (size_t)((t) * 64 + rkey) * 64 + rc8 * 8); \
        _Pragma("unroll") for (int i = 0; i < 2; ++i) vreg[i] = *(const v4u*)(VTp + (size_t)(t) * 8192 + (tid + 512 * i) * 8); } while (0)
#define ATT_WRITE(b) do { \
        _Pragma("unroll") for (int i = 0; i < 2; ++i) *(LAS v4u*)(Kb + (b) * KBYTES + (kkey + 32 * i) * (KP * 2) + kc8 * 16) = kreg[i]; \
        if (DQK == 192) *(LAS v4u*)(Kb + (b) * KBYTES + rkey * (KP * 2) + 256 + rc8 * 16) = kreg[2]; \
        _Pragma("unroll") for (int i = 0; i < 2; ++i) *(LAS v4u*)(Vb + (b) * VBYTES + (vdv + 64 * i) * (VP * 2) + vkc * 16) = vreg[i]; } while (0)
    ATT_LOAD(0); ATT_WRITE(0);
    if (ntiles > 1) ATT_LOAD(1);
    asm volatile("s_waitcnt lgkmcnt(0)" ::: "memory"); __builtin_amdgcn_s_barrier(); asm volatile("" ::: "memory");
    for (int t = 0; t < ntiles; ++t) {
        const int b = t & 1;
        if (t + 1 < ntiles) { ATT_WRITE(b ^ 1); if (t + 2 < ntiles) ATT_LOAD(t + 2); }
        const bool active = !CAUSAL || (t * 64 <= q0 + 32 * w + 31);
        if (active) {
            constexpr int BS = NS / 4;
            const LAS unsigned char* kp0 = Kb + b * KBYTES + r * (KP * 2) + hh * 16;
            const LAS unsigned char* vp0 = Vb + b * VBYTES + r * (VP * 2) + hh * 8;
            const bool need_mask = CAUSAL && (t * 64 + 63 > q0 + 32 * w);
            const int qi = q0 + 32 * w + r - t * 64 - 4 * hh;
            v16f sa0, sa1;
            const v16f zero16 = {0.f, 0.f, 0.f, 0.f, 0.f, 0.f, 0.f, 0.f, 0.f, 0.f, 0.f, 0.f, 0.f, 0.f, 0.f, 0.f};
            v8s kx[2][BS], vx[2][2];
            unsigned pw0[8], pw1[8];
            float rs0 = 0.f, rs1 = 0.f;
#define ATT_SB() __builtin_amdgcn_sched_barrier(0)
#define ATT_LDK(dst, kb, q) do { _Pragma("unroll") for (int i = 0; i < BS; ++i) dst[i] = *(const LAS v8s*)(kp0 + (kb) * (32 * KP * 2) + ((q) * BS + i) * 32); } while (0)
#define ATT_MMK(accv, src, q) do { __builtin_amdgcn_s_setprio(1); _Pragma("unroll") for (int i = 0; i < BS; ++i) accv = __builtin_amdgcn_mfma_f32_32x32x16_bf16(src[i], qf[(q) * BS + i], ((q) == 0 && i == 0) ? zero16 : accv, 0, 0, 0); __builtin_amdgcn_s_setprio(0); } while (0)
#define ATT_EXPC(sav, c, rsv_, pw) do { const float p0_ = __builtin_amdgcn_exp2f(sav[4 * (c)] - m_ref), p1_ = __builtin_amdgcn_exp2f(sav[4 * (c) + 1] - m_ref), p2_ = __builtin_amdgcn_exp2f(sav[4 * (c) + 2] - m_ref), p3_ = __builtin_amdgcn_exp2f(sav[4 * (c) + 3] - m_ref); \
                rsv_ += (p0_ + p1_) + (p2_ + p3_); pw[2 * (c)] = pk2b(p0_, p1_); pw[2 * (c) + 1] = pk2b(p2_, p3_); } while (0)
#define ATT_MASK(sav, kb) do { if (need_mask) { _Pragma("unroll") for (int j = 0; j < 16; ++j) { if (32 * (kb) + (j & 3) + 8 * (j >> 2) > qi) sav[j] = -1e30f; } } } while (0)
#define ATT_LDV(dst, db, pr) do { _Pragma("unroll") for (int i = 0; i < 2; ++i) { const int s_ = (pr) * 2 + i; const v2u lo = *(const LAS v2u*)(vp0 + (db) * (32 * VP * 2) + s_ * 32), hi = *(const LAS v2u*)(vp0 + (db) * (32 * VP * 2) + s_ * 32 + 16); \
                v4u av; av.x = lo.x; av.y = lo.y; av.z = hi.x; av.w = hi.y; dst[i] = __builtin_bit_cast(v8s, av); } } while (0)
#define ATT_MMV(db, src, pwv) do { _Pragma("unroll") for (int i = 0; i < 2; ++i) { v4u pv_; pv_.x = pwv[4 * i]; pv_.y = pwv[4 * i + 1]; pv_.z = pwv[4 * i + 2]; pv_.w = pwv[4 * i + 3]; \
                __builtin_amdgcn_s_setprio(1); o[db] = __builtin_amdgcn_mfma_f32_32x32x16_bf16(src[i], __builtin_bit_cast(v8s, pv_), o[db], 0, 0, 0); __builtin_amdgcn_s_setprio(0); } } while (0)
#define ATT_FIX(sav, other_too, forced, rsv_, pw) do { if (__builtin_amdgcn_ballot_w64((forced) || !(rsv_ < 1e12f)) != 0ull) { \
                float mx = sav[0]; _Pragma("unroll") for (int j = 1; j < 16; ++j) mx = fmaxf(mx, sav[j]); mx = fmaxf(mx, __shfl_xor(mx, 32)) - m_ref; \
                const float delta = (forced) ? mx : fmaxf(mx, 0.f); const float alpha = (forced) ? 1.f : __builtin_amdgcn_exp2f(-delta); \
                m_ref += delta; \
                l_run *= alpha; _Pragma("unroll") for (int i = 0; i < 4; ++i) o[i] = o[i] * alpha; \
                rsv_ = 0.f; ATT_EXPC(sav, 0, rsv_, pw); ATT_EXPC(sav, 1, rsv_, pw); ATT_EXPC(sav, 2, rsv_, pw); ATT_EXPC(sav, 3, rsv_, pw); } } while (0)
            ATT_LDK(kx[0], 0, 0); ATT_SB();
            ATT_LDK(kx[1], 0, 1); ATT_SB(); ATT_MMK(sa0, kx[0], 0); ATT_SB();
            ATT_LDK(kx[0], 0, 2); ATT_SB(); ATT_MMK(sa0, kx[1], 1); ATT_SB();
            ATT_LDK(kx[1], 0, 3); ATT_SB(); ATT_MMK(sa0, kx[0], 2); ATT_SB();
            ATT_LDK(kx[0], 1, 0); ATT_SB(); ATT_MMK(sa0, kx[1], 3); ATT_SB();
            ATT_MASK(sa0, 0); ATT_SB();
            ATT_LDK(kx[1], 1, 1); ATT_SB(); ATT_MMK(sa1, kx[0], 0); ATT_EXPC(sa0, 0, rs0, pw0); ATT_SB();
            ATT_LDK(kx[0], 1, 2); ATT_SB(); ATT_MMK(sa1, kx[1], 1); ATT_EXPC(sa0, 1, rs0, pw0); ATT_SB();
            ATT_LDK(kx[1], 1, 3); ATT_SB(); ATT_MMK(sa1, kx[0], 2); ATT_EXPC(sa0, 2, rs0, pw0); ATT_SB();
            ATT_LDV(vx[0], 0, 0); ATT_SB(); ATT_MMK(sa1, kx[1], 3); ATT_EXPC(sa0, 3, rs0, pw0); ATT_SB();
            ATT_MASK(sa1, 1);
            ATT_FIX(sa0, true, t == 0, rs0, pw0);
            l_run += rs0; ATT_SB();
            ATT_LDV(vx[1], 1, 0); ATT_SB(); ATT_MMV(0, vx[0], pw0); ATT_EXPC(sa1, 0, rs1, pw1); ATT_SB();
            ATT_LDV(vx[0], 2, 0); ATT_SB(); ATT_MMV(1, vx[1], pw0); ATT_EXPC(sa1, 1, rs1, pw1); ATT_SB();
            ATT_LDV(vx[1], 3, 0); ATT_SB(); ATT_MMV(2, vx[0], pw0); ATT_EXPC(sa1, 2, rs1, pw1); ATT_SB();
            ATT_LDV(vx[0], 0, 1); ATT_SB(); ATT_MMV(3, vx[1], pw0); ATT_EXPC(sa1, 3, rs1, pw1); ATT_SB();
            ATT_FIX(sa1, false, false, rs1, pw1);
            l_run += rs1; ATT_SB();
            ATT_LDV(vx[1], 1, 1); ATT_SB(); ATT_MMV(0, vx[0], pw1); ATT_SB();
            ATT_LDV(vx[0], 2, 1); ATT_SB(); ATT_MMV(1, vx[1], pw1); ATT_SB();
            ATT_LDV(vx[1], 3, 1); ATT_SB(); ATT_MMV(2, vx[0], pw1); ATT_SB();
            ATT_MMV(3, vx[1], pw1); ATT_SB();
#undef ATT_SB
#undef ATT_LDK
#undef ATT_MMK
#undef ATT_EXPC
#undef ATT_MASK
#undef ATT_LDV
#undef ATT_MMV
#undef ATT_FIX
        }
        asm volatile("s_waitcnt lgkmcnt(0)" ::: "memory"); __builtin_amdgcn_s_barrier(); asm volatile("" ::: "memory");
    }
#undef ATT_LOAD
#undef ATT_WRITE
    const float ltot = l_run + __shfl_xor(l_run, 32);
    const float inv = 1.0f / ltot;
    bf16* orow = Op + (size_t)(32 * w + r) * opitch + 8 * hh;
#pragma unroll
    for (int db = 0; db < 4; ++db)
#pragma unroll
        for (int gp = 0; gp < 2; ++gp) {
            const int g = 2 * gp;
            unsigned ax = pk2b(o[db][4 * g] * inv, o[db][4 * g + 1] * inv), ay = pk2b(o[db][4 * g + 2] * inv, o[db][4 * g + 3] * inv);
            unsigned bx = pk2b(o[db][4 * g + 4] * inv, o[db][4 * g + 5] * inv), by = pk2b(o[db][4 * g + 6] * inv, o[db][4 * g + 7] * inv);
            const auto rx = __builtin_amdgcn_permlane32_swap(ax, bx, false, false); ax = rx[0]; bx = rx[1];
            const auto ry = __builtin_amdgcn_permlane32_swap(ay, by, false, false); ay = ry[0]; by = ry[1];
            v4u ov; ov.x = ax; ov.y = ay; ov.z = bx; ov.w = by;
            *(v4u*)(orow + 32 * db + 16 * gp) = ov;
        }
}

__device__ __forceinline__ unsigned my_xcc_id() { return (unsigned)__builtin_amdgcn_s_getreg((3 << 11) | 20) & 7u; }
__device__ __forceinline__ void attn_phase(const Args& a, LAS unsigned char* lds, bool layerB, int rep) {
    unsigned char* ws = a.ws;
    unsigned* qbase = (unsigned*)(ws + WS_CTL) + CTL_QUEUE + (layerB ? 128 : 0) + 256 * rep;
    volatile LAS unsigned* slot = (volatile LAS unsigned*)(lds + LDS_MISC);
    const int ncausal = layerB ? 96 : 0, total = ncausal + 32;
    bf16* MIX = (bf16*)(ws + (layerB ? WS_MIXB : WS_MIXA));
    const bf16* MQ = (const bf16*)(ws + (layerB ? WS_MQB : WS_MQ));
    const unsigned myx = my_xcc_id();
    for (int k = 0; k < 8; ++k) {
        const int x = (int)((myx + k) & 7u);
        unsigned* qctr = qbase + 16 * x;
        for (;;) {
            __syncthreads();
            if (threadIdx.x == 0) slot[0] = atomicAdd(qctr, 1u);
            __syncthreads();
            const int idx = (int)slot[0];
            if (idx >= total) break;
            if (idx < ncausal) {
                const int qb = 15 - idx / 6, bh = x + 8 * (idx % 6), b = bh / 12, h = bh % 12;
                const size_t tok0 = (size_t)b * SEQ;
                attn_unit<192, true>(lds, (const bf16*)(ws + WS_Q) + (tok0 + 256 * qb) * 2304 + h * 192, 2304,
                                     (const bf16*)(ws + WS_KN) + tok0 * 1536 + h * 128, 1536, (const bf16*)(ws + WS_KR) + tok0 * 64,
                                     (const bf16*)(ws + WS_VT) + (size_t)(h * 256 + b * 64) * 8192,
                                     MIX + (tok0 + 256 * qb) * DM + h * 128, DM, 4 * (qb + 1), 256 * qb);
            } else {
                const int mi = x * 32 + (idx - ncausal), qblk = mi >> 2, h = mi & 3, b = qblk >> 4, l = layerB ? 1 : 0;
                const size_t row0 = (size_t)qblk * 256;
                attn_unit<128, false>(lds, MQ + row0 * 512 + h * 128, 512,
                                      (const bf16*)(ws + WS_KMEM) + (size_t)(b * 256) * 1024 + l * 512 + h * 128, 1024, nullptr,
                                      (const bf16*)(ws + WS_VMT) + (size_t)((l * 4 + h) * 16 + b * 4) * 8192,
                                      MIX + row0 * DM + TOKW + h * 128, DM, 4, 0);
            }
        }
    }
}

#define XB_TMO      128
#define XB_XCNT(j)  (256  + 64 * (j))
#define XB_XSUB(j)  (1280 + 64 * (j))
#define XB_XGEN(j)  (2304 + 64 * (j))
#define XB_TOP      3328
#define XB_TOPGEN   3392
#define XCD_BAR_WORDS 3456
#define XB_SPIN_CAP (1u << 18)

__device__ __forceinline__ unsigned xb_ld(unsigned* p)              { return __hip_atomic_load(p, __ATOMIC_RELAXED, __HIP_MEMORY_SCOPE_AGENT); }
__device__ __forceinline__ unsigned xb_add(unsigned* p, unsigned v) { return __hip_atomic_fetch_add(p, v, __ATOMIC_RELAXED, __HIP_MEMORY_SCOPE_AGENT); }
__device__ __forceinline__ unsigned xb_xcc_id() { return (unsigned)__builtin_amdgcn_s_getreg((3 << 11) | 20) & 0xFu; }
#define XB_SPIN(cond, bar) do { unsigned _sp = 0; while (cond) { __builtin_amdgcn_s_sleep(1); \
    if ((++_sp & 255u) == 0u) { if (xb_ld(&(bar)[XB_TMO])) break; if (_sp > XB_SPIN_CAP) { atomicAdd(&(bar)[XB_TMO], 1u); break; } } } } while (0)

struct XcdBarrier {
    unsigned* bar; unsigned x;
    volatile LAS unsigned* st;
};

__device__ __forceinline__ XcdBarrier xcd_barrier_post(unsigned* bar, volatile LAS unsigned* st) {
    XcdBarrier b; b.bar = bar; b.x = xb_xcc_id(); b.st = st;
    if (threadIdx.x == 0) (void)xb_add(&bar[XB_XCNT(b.x)], 1u);
    return b;
}
__device__ __forceinline__ void xcd_barrier_complete(unsigned* bar, unsigned x, unsigned& nloc, unsigned& nx) {
    const unsigned G = gridDim.x * gridDim.y * gridDim.z;
    unsigned sum, cnt, mine, sp = 0u;
    for (;;) {
        sum = 0u; cnt = 0u; mine = 0u;
#pragma unroll
        for (unsigned j = 0; j < 16; ++j) { const unsigned c = xb_ld(&bar[XB_XCNT(j)]); sum += c; cnt += (c > 0u) ? 1u : 0u; mine = (j == x) ? c : mine; }
        if (sum == G) break;
        __builtin_amdgcn_s_sleep(1);
        if ((++sp & 255u) == 0u) { if (xb_ld(&bar[XB_TMO])) break; if (sp > XB_SPIN_CAP) { atomicAdd(&bar[XB_TMO], 1u); break; } }
    }
    nloc = mine > 0u ? mine : 1u; nx = cnt > 0u ? cnt : 1u;
}

__device__ __forceinline__ void xcd_barrier(const XcdBarrier& b) {
    asm volatile("s_waitcnt vmcnt(0)" ::: "memory");
    __syncthreads();
    if (threadIdx.x == 0) {
        unsigned* bar = b.bar;
        __builtin_amdgcn_s_waitcnt(0);
        unsigned nloc = b.st[0], nx = b.st[1];
        if (nloc == 0u) { xcd_barrier_complete(bar, b.x, nloc, nx); b.st[0] = nloc; b.st[1] = nx; }
        const unsigned old = xb_add(&bar[XB_XSUB(b.x)], 1u);
        const unsigned gen = old / nloc;
        if (old + 1u == (gen + 1u) * nloc) {
            __builtin_amdgcn_fence(__ATOMIC_RELEASE, "agent");
            asm volatile("s_waitcnt vmcnt(0)" ::: "memory");
            const unsigned og = xb_add(&bar[XB_TOP], 1u);
            const unsigned tg = og / nx;
            if (og + 1u == (tg + 1u) * nx) xb_add(&bar[XB_TOPGEN], 1u);
            else XB_SPIN(xb_ld(&bar[XB_TOPGEN]) == tg, bar);
            __builtin_amdgcn_fence(__ATOMIC_ACQUIRE, "agent");
            xb_add(&bar[XB_XGEN(b.x)], 1u);
            asm volatile("s_waitcnt vmcnt(0)" ::: "memory");
        } else {
            XB_SPIN(xb_ld(&bar[XB_XGEN(b.x)]) == gen, bar);
            __builtin_amdgcn_fence(__ATOMIC_ACQUIRE, "agent");
            asm volatile("s_waitcnt vmcnt(0)" ::: "memory");
        }
    }
    __syncthreads();
}

__device__ __forceinline__ void tile_of(int nM, int nN, int wg, pg8::Unit& u) {
    const int nwg = nM * nN, q = nwg / 8, r = nwg % 8, xcd = wg % 8, off = wg / 8;
    wg = (xcd < r ? xcd * (q + 1) : r * (q + 1) + (xcd - r) * q) + off;
    const int nig = 8 * nN, gid = wg / nig, fm = gid * 8, gsz = (nM - fm) < 8 ? (nM - fm) : 8;
    u.pm = fm + ((wg % nig) % gsz); u.pn = (wg % nig) / gsz;
}
struct Order {
    pg8::StaticOrder s; int mode, G, c;
    __device__ __forceinline__ bool next(int i, pg8::Unit& u) const {
        if (mode == 0) return s.next(i, u);
        const int L = i * G + c;
        if (L < 384) { tile_of(64, 6, L, u); u.pm += VT_CKV; u.pn += VT_WUK; return true; }
        if (L < 768) { tile_of(6, 64, L - 384, u); u.pm += VT_WUV; u.pn += VT_CKV; return true; }
        if (L < 1344) { tile_of(64, 9, L - 768, u); u.pm += VT_ZQ; u.pn += VT_WUQ; return true; }
        return false;
    }
    __device__ __forceinline__ void a_ready(const pg8::Unit&) const {}
    __device__ __forceinline__ void done(const pg8::Unit&) const {}
};

__device__ __forceinline__ bool gemm_job(const Args& a, int p, int j, pg8::Gemm& g, Epi& E, int& rot) {
    unsigned char* ws = a.ws; float* ctl = (float*)(ws + WS_ST);
    E.kind = EK_STORE; E.scale_mode = 0; E.accss = 0; E.ldc = DM; E.o0 = nullptr; E.ssin = nullptr; E.inv_n = 0.f; E.ss0 = nullptr; E.nslots = 32; E.vt_nt = 0; E.wsb = ws; E.pm_cached = -1; E.lrs = nullptr; rot = 0;
#define BF(off) ((bf16*)(ws + (off)))
    switch (p) {
    case 1:
        if (j == 0) { g = pg8::Gemm{BF(WS_HN), BF(WS_WAIN), NTOK, 3584, 2048}; E.kind = EK_AIN; return true; }
        if (j == 1) { g = pg8::Gemm{BF(WS_MEMN), BF(WS_WMK), 1024, 1024, 2048}; E.o0 = BF(WS_KMEM); E.ldc = 1024; rot = 128; return true; }
        if (j == 2) { g = pg8::Gemm{BF(WS_WMV), BF(WS_MEMN), 1024, 1024, 2048}; E.o0 = BF(WS_VMT); E.ldc = 1024; E.vt_nt = 16; rot = 112; return true; }
        return false;
    case 3: case 11:
        if (j == 0) { g = pg8::Gemm{BF(p == 3 ? WS_MIXA : WS_MIXB), BF(p == 3 ? WS_WAOUT : WS_WBOUT), NTOK, DM, DM}; E.o0 = BF(WS_GOUT); E.accss = 1; E.ss0 = ctl + ST_G; return true; }
        return false;
    case 5: case 13:
        if (j == 0) { g = pg8::Gemm{BF(WS_HN), BF(p == 13 ? WS_WGU1 : WS_WGU0), NTOK, 11264, 2048}; E.kind = EK_GATEUP; E.o0 = BF(WS_ACT); return true; }
        return false;
    case 6: case 14:
        if (j == 0) { g = pg8::Gemm{BF(WS_ACT), BF(p == 14 ? WS_WDN1 : WS_WDN0), NTOK, DM, DFF}; E.o0 = BF(WS_GOUT); E.accss = 1; E.ss0 = ctl + ST_G; return true; }
        return false;
    case 8:
        if (j == 0) { g = pg8::Gemm{BF(WS_HN), BF(WS_WBIN), NTOK, 1792, 2048}; E.kind = EK_BIN; return true; }
        return false;
    case 9:
        if (j == 0) { g = pg8::Gemm{BF(0), BF(0), 256, 256, 512}; E.kind = EK_P9; E.inv_n = 1.f / 512.f; rot = -1; return true; }
        return false;
    default: return false;
    }
#undef BF
}

#ifndef PROBE_REP
#define PROBE_REP (-1)
#endif
__global__ void __launch_bounds__(512, 2) yoco_fwd(Args a) {
    extern __shared__ __attribute__((aligned(16))) unsigned char lds_raw[];
    LAS unsigned char* lds = (LAS unsigned char*)lds_raw;
    cg::grid_group grid = cg::this_grid();
    unsigned char* ws = a.ws; const float* ng = a.in[3];
    volatile LAS unsigned* misc = (volatile LAS unsigned*)(lds + LDS_MISC);
    if (threadIdx.x < 16) misc[threadIdx.x] = 0u;
    __syncthreads();
    XcdBarrier bar = xcd_barrier_post((unsigned*)(ws + WS_CTL) + CW_BAR, misc + 8);
    for (int p = a.ph_lo; p < a.ph_hi; ++p) {
        const int nrep = (p == PROBE_REP) ? 2 : 1;
        for (int rp = 0; rp < nrep; ++rp) {
            if (rp) xcd_barrier(bar);
            if (p == 0) prologue(a, lds);
            else if (p == 2 || p == 10) { if (p == 2) gating_phase(a, lds); attn_phase(a, lds, p == 10, rp); }
            else if (p == 4 || p == 7 || p == 12 || p == 15) {
                const float* ss = (const float*)(ws + WS_ST) + ST_G;
                const float* gain = ng + (p == 4 ? 1 : (p == 7 ? 3 : (p == 12 ? 5 : 7))) * 2048;
                rowpass(p == 4 ? a.in[0] : nullptr, (bf16*)(ws + WS_HN), (const bf16*)(ws + WS_GOUT), ss, gain, (float*)(ws + WS_HSS), p == 15 ? a.out : nullptr);
            } else {
                for (int j = 0;; ++j) {
                    pg8::Gemm g; Epi E; int rot;
                    if (!gemm_job(a, p, j, g, E, rot)) break;
                    Order S; S.mode = rot < 0 ? 1 : 0; S.G = (int)gridDim.x; S.c = (int)blockIdx.x; if (rot < 0) rot = 0;
                    S.s.init(g.M, g.N, (int)gridDim.x, (int)((blockIdx.x + rot) % gridDim.x));
                    if (E.kind == EK_GATEUP || E.kind == EK_BIN) {
                        pg8::Unit u0; LAS float* lrs = (LAS float*)(lds + LDS_MISC + 1024);
                        if (S.next(0, u0)) { if (threadIdx.x < 256) lrs[threadIdx.x] = __builtin_amdgcn_rsqf(((const float*)(ws + WS_HSS))[u0.pm * 256 + threadIdx.x] * (1.f / DM) + EPS); E.pm_cached = u0.pm; E.lrs = lrs; }
                        __syncthreads();
                    }
                    pg8::gemm_phase<Epi, Order, true, true>(lds, g, S, E);
                }
            }
        }
        if (p + 1 < a.ph_hi) { if (p == 0) grid.sync(); else xcd_barrier(bar); }
    }
}

extern "C" void kernel_launch(void* const* d_in, const int* in_sizes, int n_in, void* d_out, int out_size, void* d_ws, size_t ws_size, hipStream_t stream) {
    static int grid = 0;
    if (grid == 0) {
        if (n_in != 24 || out_size != NTOK * DM || ws_size < WS_END) { fprintf(stderr, "kernel_launch: unexpected shapes (n_in %d out %d ws %zu)\n", n_in, out_size, ws_size); grid = -1; return; }
        int dev = 0, cus = 0, per_cu = 0;
        hipGetDevice(&dev); hipDeviceGetAttribute(&cus, hipDeviceAttributeMultiprocessorCount, dev);
        if (hipFuncSetAttribute((const void*)yoco_fwd, hipFuncAttributeMaxDynamicSharedMemorySize, LDS_BYTES) != hipSuccess) { fprintf(stderr, "kernel_launch: hipFuncSetAttribute failed\n"); grid = -1; return; }
        hipOccupancyMaxActiveBlocksPerMultiprocessor(&per_cu, (const void*)yoco_fwd, 512, LDS_BYTES);
        (void)hipGetLastError();
        if (per_cu < 1) per_cu = 1;
        grid = cus * per_cu;
        fprintf(stderr, "kernel_launch: grid %d (%d CUs x %d)\n", grid, cus, per_cu);
    }
    if (grid < 0) return;
    if (hipMemsetAsync((char*)d_ws + WS_CTL, 0, CTL_ZERO_BYTES, stream) != hipSuccess) { fprintf(stderr, "kernel_launch: memset failed\n"); return; }
    Args a{};
    for (int i = 0; i < 24; ++i) a.in[i] = (const float*)d_in[i];
    a.out = (float*)d_out; a.ws = (unsigned char*)d_ws;
#ifndef N_CUTS
    a.ph_lo = 0; a.ph_hi = 16;
    void* args[] = {&a};
    hipError_t e = hipLaunchCooperativeKernel((const void*)yoco_fwd, dim3(grid), dim3(512), args, LDS_BYTES, stream);
    if (e != hipSuccess) fprintf(stderr, "cooperative launch failed: %s (grid %d)\n", hipGetErrorString(e), grid);
#else
    for (int p = 0; p < 16; ++p) { a.ph_lo = p; a.ph_hi = p + 1; void* args[] = {&a};
        hipError_t e = hipLaunchCooperativeKernel((const void*)yoco_fwd, dim3(grid), dim3(512), args, LDS_BYTES, stream);
        if (e != hipSuccess) { fprintf(stderr, "launch %d failed: %s\n", p, hipGetErrorString(e)); break; } }
#endif
}
```
